# Optimizing an MI355X kernel written in HIP

```python
import jax, jax.numpy as jnp
from jax import lax
import numpy as np

D_MODEL = 1024
BATCH = 32
SEQ = 2048
DEPTH = 4
DEC_BATCH = 32
DEC_SEQ = 64
PAST_LEN = 2048

CHUNK = 64
CONV_WIDTH = 3
D_CONV = D_MODEL
N_HEADS = 8
QK_NOPE = 128
QK_ROPE = 64
QK_DIM = QK_NOPE + QK_ROPE
V_DIM = D_MODEL // N_HEADS
Q_LORA = 384
KV_LORA = 256
D_FF = 4 * D_MODEL
ROPE_THETA = 10000.0
EPS = 1e-6
Q_BLOCK = 128
SM_SCALE = QK_DIM ** -0.5
NEG_INF = -1e30

OFF_C = D_CONV
OFF_X = 2 * D_CONV
OFF_Q = 3 * D_CONV
OFF_KV = OFF_Q + Q_LORA
OFF_PE = OFF_KV + KV_LORA
OFF_GA = OFF_PE + QK_ROPE
OFF_GB = OFF_GA + D_MODEL
D_IN = OFF_GB + D_MODEL

kernel_name = "hybrid_shortconv_mla_stream_step"


def rmsnorm(x, g):
    xf = x.astype(jnp.float32)
    y = xf * lax.rsqrt(jnp.mean(xf * xf, axis=-1, keepdims=True) + EPS)
    return (y * g.astype(jnp.float32)).astype(x.dtype)


def rope_tables(pos):
    inv = ROPE_THETA ** (-jnp.arange(0, QK_ROPE, 2, dtype=jnp.float32) / QK_ROPE)
    ang = pos.astype(jnp.float32)[:, None] * inv[None, :]
    return jnp.cos(ang), jnp.sin(ang)


def apply_rope(x, cos, sin):
    if x.ndim == 4:
        cos, sin = cos[:, None, :], sin[:, None, :]
    xf = x.astype(jnp.float32)
    x1, x2 = jnp.split(xf, 2, axis=-1)
    out = jnp.concatenate([x1 * cos - x2 * sin, x2 * cos + x1 * sin], axis=-1)
    return out.astype(x.dtype)


def short_conv(u, buf, w):
    L = u.shape[1]
    full = jnp.concatenate([buf, u], axis=1)
    y = sum(w[k][None, None, :] * full[:, k:k + L] for k in range(CONV_WIDTH))
    return y, full[:, -(CONV_WIDTH - 1):]


def mla_attention(q_nope, q_pe, q_pos, ckv, kpe, k_pos, w_uk, w_uv):
    B, Lq = q_nope.shape[0], q_nope.shape[1]
    k_nope = jnp.einsum('bkc,chd->bkhd', ckv, w_uk.reshape(KV_LORA, N_HEADS, QK_NOPE))
    v = jnp.einsum('bkc,chd->bkhd', ckv, w_uv.reshape(KV_LORA, N_HEADS, V_DIM))
    k_chunk = k_pos // CHUNK
    qb = min(Q_BLOCK, Lq)
    nb = Lq // qb
    qn_b = jnp.moveaxis(q_nope.reshape(B, nb, qb, N_HEADS, QK_NOPE), 1, 0)
    qp_b = jnp.moveaxis(q_pe.reshape(B, nb, qb, N_HEADS, QK_ROPE), 1, 0)
    qpos_b = q_pos.reshape(nb, qb)

    def block(args):
        qn, qp, qpos = args
        s = (jnp.einsum('bqhd,bkhd->bhqk', qn, k_nope)
             + jnp.einsum('bqhr,bkr->bhqk', qp, kpe)).astype(jnp.float32) * SM_SCALE
        mask = k_chunk[None, :] <= (qpos // CHUNK)[:, None]
        s = jnp.where(mask[None, None], s, NEG_INF)
        p = jax.nn.softmax(s, axis=-1).astype(v.dtype)
        return jnp.einsum('bhqk,bkhd->bqhd', p, v)

    out = lax.map(block, (qn_b, qp_b, qpos_b))
    return jnp.moveaxis(out, 0, 1).reshape(B, Lq, N_HEADS * V_DIM)


def layer(x, pos, conv_buf, past_ckv, past_kpe, past_pos,
          w_in, conv_w, w_uq, w_uk, w_uv, w_o, w1, w2,
          g_pre_mix, g_post_mix, g_pre_ffn, g_post_ffn, g_q, g_kv):
    B, L, _ = x.shape
    h = rmsnorm(x, g_pre_mix)
    z = h @ w_in
    b_g, c_g, xin, cq, ckv_raw, kpe_raw, ga, gb = jnp.split(
        z, [OFF_C, OFF_X, OFF_Q, OFF_KV, OFF_PE, OFF_GA, OFF_GB], axis=-1)
    yc, new_buf = short_conv(c_g * xin, conv_buf, conv_w)
    y_a = b_g * yc
    cos, sin = rope_tables(pos)
    q = (rmsnorm(cq, g_q) @ w_uq).reshape(B, L, N_HEADS, QK_DIM)
    q_nope, q_pe = q[..., :QK_NOPE], apply_rope(q[..., QK_NOPE:], cos, sin)
    ckv_new = rmsnorm(ckv_raw, g_kv)
    kpe_new = apply_rope(kpe_raw, cos, sin)
    if past_ckv is None:
        ckv_all, kpe_all, k_pos = ckv_new, kpe_new, pos
    else:
        ckv_all = jnp.concatenate([past_ckv, ckv_new], axis=1)
        kpe_all = jnp.concatenate([past_kpe, kpe_new], axis=1)
        k_pos = jnp.concatenate([past_pos, pos])
    y_b = mla_attention(q_nope, q_pe, pos, ckv_all, kpe_all, k_pos, w_uk, w_uv)
    merged = jax.nn.sigmoid(ga) * y_a + jax.nn.sigmoid(gb) * y_b
    x = x + rmsnorm(merged @ w_o, g_post_mix)
    f = jnp.square(jax.nn.relu(rmsnorm(x, g_pre_ffn) @ w1)) @ w2
    x = x + rmsnorm(f, g_post_ffn)
    return x, new_buf, ckv_new, kpe_new


def setup_inputs(seed: int = 0) -> dict:
    key = jax.random.key(seed)
    ks = jax.random.split(key, 24)
    f32 = jnp.float32

    def nrm(k, shape, scale):
        return jax.random.normal(k, shape, f32) * scale

    def gain(k, n):
        return 1.0 + 0.05 * jax.random.normal(k, (DEPTH, n), f32)

    return {
        "x_prompt": nrm(ks[0], (BATCH, SEQ, D_MODEL), 1.0),
        "x_sample": nrm(ks[1], (DEC_BATCH, DEC_SEQ, D_MODEL), 1.0),
        "cache_ckv": nrm(ks[2], (DEPTH, DEC_BATCH, PAST_LEN, KV_LORA), 1.0),
        "cache_kpe": nrm(ks[3], (DEPTH, DEC_BATCH, PAST_LEN, QK_ROPE), 1.0),
        "state_conv": nrm(ks[4], (DEPTH, DEC_BATCH, CONV_WIDTH - 1, D_CONV), 1.0),
        "w_in": nrm(ks[5], (DEPTH, D_MODEL, D_IN), D_MODEL ** -0.5),
        "conv_w": nrm(ks[6], (DEPTH, CONV_WIDTH, D_CONV), CONV_WIDTH ** -0.5),
        "w_uq": nrm(ks[7], (DEPTH, Q_LORA, N_HEADS * QK_DIM), Q_LORA ** -0.5),
        "w_uk": nrm(ks[8], (DEPTH, KV_LORA, N_HEADS * QK_NOPE), KV_LORA ** -0.5),
        "w_uv": nrm(ks[9], (DEPTH, KV_LORA, N_HEADS * V_DIM), KV_LORA ** -0.5),
        "w_o": nrm(ks[10], (DEPTH, D_MODEL, D_MODEL), D_MODEL ** -0.5),
        "w1": nrm(ks[11], (DEPTH, D_MODEL, D_FF), D_MODEL ** -0.5),
        "w2": nrm(ks[12], (DEPTH, D_FF, D_MODEL), D_FF ** -0.5),
        "g_pre_mix": gain(ks[13], D_MODEL),
        "g_post_mix": gain(ks[14], D_MODEL),
        "g_pre_ffn": gain(ks[15], D_MODEL),
        "g_post_ffn": gain(ks[16], D_MODEL),
        "g_q": gain(ks[17], Q_LORA),
        "g_kv": gain(ks[18], KV_LORA),
    }


def reference(x_prompt, x_sample, cache_ckv, cache_kpe, state_conv,
              w_in, conv_w, w_uq, w_uk, w_uv, w_o, w1, w2,
              g_pre_mix, g_post_mix, g_pre_ffn, g_post_ffn, g_q, g_kv):
    B, S, _ = x_prompt.shape
    P = cache_ckv.shape[2]
    Ls = x_sample.shape[1]
    pos_p = jnp.arange(S, dtype=jnp.int32)
    past_pos = jnp.arange(P, dtype=jnp.int32)
    pos_s = P + jnp.arange(Ls, dtype=jnp.int32)
    zero_buf = jnp.zeros((B, CONV_WIDTH - 1, D_CONV), x_prompt.dtype)

    xp, xs = x_prompt, x_sample
    ckv_p, kpe_p, conv_p, ckv_s, kpe_s, conv_s = [], [], [], [], [], []
    for l in range(DEPTH):
        wl = (w_in[l], conv_w[l], w_uq[l], w_uk[l], w_uv[l], w_o[l], w1[l], w2[l],
              g_pre_mix[l], g_post_mix[l], g_pre_ffn[l], g_post_ffn[l], g_q[l], g_kv[l])
        xp, bp, cp, kp = layer(xp, pos_p, zero_buf, None, None, None, *wl)
        xs, bs, cs, ksm = layer(xs, pos_s, state_conv[l], cache_ckv[l], cache_kpe[l],
                                past_pos, *wl)
        ckv_p.append(cp); kpe_p.append(kp); conv_p.append(bp)
        ckv_s.append(cs); kpe_s.append(ksm); conv_s.append(bs)

    return (xp, xs,
            jnp.stack(ckv_p), jnp.stack(kpe_p), jnp.stack(conv_p),
            jnp.stack(ckv_s), jnp.stack(kpe_s), jnp.stack(conv_s))
```

```cpp
#include <hip/hip_runtime.h>
#include <hip/hip_cooperative_groups.h>
#include <cstdio>
#include <cstdint>
namespace cg = cooperative_groups;

#ifndef MK_MULTI
#define MK_MULTI 0
#endif

#define LAS __attribute__((address_space(3)))
#define GAS __attribute__((address_space(1)))
typedef unsigned short bf16_t;
typedef short bf16x8 __attribute__((ext_vector_type(8)));
typedef float f32x4 __attribute__((ext_vector_type(4)));
typedef float f32x2 __attribute__((ext_vector_type(2)));
typedef float f32x16 __attribute__((ext_vector_type(16)));
typedef unsigned u32x4 __attribute__((ext_vector_type(4)));
typedef unsigned u32x2 __attribute__((ext_vector_type(2)));
typedef __bf16 bf16x2_t __attribute__((ext_vector_type(2)));

constexpr int DM = 1024, NBATCH = 32, SEQ = 2048, DEPTH = 4, DSEQ = 64, PAST = 2048;
constexpr int NHEAD = 8, QKD = 192, QL = 384, KVL = 256, DFF = 4096, DIN = 5824;
constexpr int NG = 2, GB = NBATCH / NG;
constexpr int TP = GB * SEQ, TS = GB * DSEQ, TG = TP + TS, TPAST = GB * PAST, TA = TG + TPAST;
constexpr int NWIN = 5888, NQ = 1536, ZSW = 768;
constexpr int NPOS = PAST + DSEQ;
constexpr float EPS = 1e-6f;
constexpr float QSCALE = 0.07216878364870322f * 1.4426950408889634f;
static_assert(TG % 256 == 0 && TA % 256 == 0, "row tiles");

__device__ __forceinline__ unsigned pk2(float lo, float hi) { f32x2 v = {lo, hi}; bf16x2_t b = __builtin_convertvector(v, bf16x2_t); return __builtin_bit_cast(unsigned, b); }
__device__ __forceinline__ float bflo(unsigned w) { return __uint_as_float(w << 16); }
__device__ __forceinline__ float bfhi(unsigned w) { return __uint_as_float(w & 0xffff0000u); }
__device__ __forceinline__ float sigmoidf_(float x) { return __builtin_amdgcn_rcpf(1.0f + __builtin_amdgcn_exp2f(-1.4426950408889634f * x)); }
__device__ __forceinline__ float wave_sum(float v) {
#pragma unroll
    for (int o = 1; o < 64; o <<= 1) v += __shfl_xor(v, o);
    return v;
}
__device__ __forceinline__ int row_pos(int R) { return R < TP ? (R & (SEQ - 1)) : PAST + ((R - TP) & (DSEQ - 1)); }

namespace pg8 {
#define PG8_LAS __attribute__((address_space(3)))
constexpr int BM = 256, BK = 64, HALF = 128, HTB = HALF * BK * 2, STAGE_BYTES = 8 * HTB, NXCD = 8, WGM = 8;

__host__ __device__ __forceinline__ int lds_byte(int r, int c) { const int st = (r >> 4) * 2 + (c >> 5), rr = r & 15, cc = c & 31, ob = rr * 64 + cc * 2; return st * 1024 + (ob ^ (((ob >> 9) & 1) << 5)); }
__host__ __device__ __forceinline__ void stage_rc(int b, int& R, int& C) { const int st = b / 1024, sb = b % 1024, swz = sb ^ (((sb >> 9) & 1) << 5); R = (st >> 1) * 16 + swz / 64; C = (st & 1) * 32 + (swz % 64) / 2; }
__host__ __device__ __forceinline__ int perm32(int rho) { const int n = rho >> 4, i = rho & 15; return 8 * (i >> 2) + 4 * n + (i & 3); }

struct Unit { int pm, pn, ks; };
struct Gemm { const bf16_t* A; const bf16_t* Bt; int M, N, K, lda, ldb; };
__device__ __forceinline__ Gemm mkgemm(const bf16_t* A, const bf16_t* Bt, int M, int N, int K) { return Gemm{A, Bt, M, N, K, K, K}; }

struct StaticOrder {
    int nM, nN, nwg, G, c;
    __host__ __device__ void init(int M, int N, int G_, int c_) { nM = M / BM; nN = N / BM; nwg = nM * nN; G = G_; c = c_; }
    __host__ __device__ bool next(int i, Unit& u) const {
        const long L = (long)i * G + c; if (L >= nwg) return false;
        int wgid = (int)L; { const int q = nwg / NXCD, r = nwg % NXCD, xcd = wgid % NXCD, off = wgid / NXCD; wgid = (xcd < r ? xcd * (q + 1) : r * (q + 1) + (xcd - r) * q) + off; }
        const int nig = WGM * nN, gid = wgid / nig, fm = gid * WGM, gsz = (nM - fm) < WGM ? (nM - fm) : WGM;
        u.pm = fm + ((wgid % nig) % gsz); u.pn = (wgid % nig) / gsz; u.ks = 0; return true;
    }
    __device__ __forceinline__ void a_ready(const Unit&) const {}
    __device__ __forceinline__ void done(const Unit&) const {}
};

struct SplitOrder {
    int nN, nS, nwg, G, c;
    __host__ __device__ void init(int M, int N, int nS_, int G_, int c_) { nN = N / BM; nS = nS_; nwg = (M / BM) * nN * nS; G = G_; c = c_; }
    __host__ __device__ bool next(int i, Unit& u) const { const long L = (long)i * G + c; if (L >= nwg) return false; const int l = (int)L; u.ks = l % nS; const int t = l / nS; u.pn = t % nN; u.pm = t / nN; return true; }
    __device__ __forceinline__ void a_ready(const Unit&) const {}
    __device__ __forceinline__ void done(const Unit&) const {}
};

template <int ACT> struct EpiPlain {
    static constexpr bool PERM = true, AFTER_DRAIN = false;
    bf16_t* O; long ldc; const float* rs;
    __device__ __forceinline__ void operator()(const f32x4 (&acc)[2][2][4][2], const Unit& u, int wr, int wc, int fr, int fq) const {
        const int row0 = u.pm * BM + wr * 64 + fr; const int col0 = u.pn * BM + wc * 32 + 8 * fq;
#pragma unroll
        for (int ai = 0; ai < 2; ++ai)
#pragma unroll
            for (int m = 0; m < 4; ++m) { bf16_t* rowp = O + (size_t)(row0 + ai * HALF + m * 16) * ldc + col0; float rsv = 1.f; if (ACT == 1) rsv = rs[row0 + ai * HALF + m * 16];
#pragma unroll
                for (int bj = 0; bj < 2; ++bj) { f32x4 v0 = acc[ai][bj][m][0], v1 = acc[ai][bj][m][1];
                    if (ACT == 1) {
#pragma unroll
                        for (int j = 0; j < 4; ++j) { const float a = fmaxf(v0[j] * rsv, 0.f), b = fmaxf(v1[j] * rsv, 0.f); v0[j] = a * a; v1[j] = b * b; } }
                    u32x4 w; w.x = pk2(v0[0], v0[1]); w.y = pk2(v0[2], v0[3]); w.z = pk2(v1[0], v1[1]); w.w = pk2(v1[2], v1[3]);
                    *(u32x4*)(rowp + bj * HALF) = w; } }
    }
};

struct EpiPartial {
    static constexpr bool PERM = false, AFTER_DRAIN = false;
    float* P; long ldc; long sstride;
    __device__ __forceinline__ void operator()(const f32x4 (&acc)[2][2][4][2], const Unit& u, int wr, int wc, int fr, int fq) const {
        float* base = P + (size_t)u.ks * sstride + (size_t)(u.pm * BM + wr * 64 + fr) * ldc + u.pn * BM + wc * 32 + fq * 4;
#pragma unroll
        for (int ai = 0; ai < 2; ++ai)
#pragma unroll
            for (int m = 0; m < 4; ++m) { float* rowp = base + (size_t)(ai * HALF + m * 16) * ldc;
#pragma unroll
                for (int bj = 0; bj < 2; ++bj)
#pragma unroll
                    for (int n = 0; n < 2; ++n) *(f32x4*)(rowp + bj * HALF + n * 16) = acc[ai][bj][m][n]; }
    }
};

struct EpiWin {
    static constexpr bool PERM = true, AFTER_DRAIN = false;
    bf16_t *S1, *U, *GBS, *ZS; const float* rs; float* convp; float* convs;
    __device__ __forceinline__ void operator()(const f32x4 (&acc)[2][2][4][2], const Unit& u, int wr, int wc, int fr, int fq) const {
        const int row0 = u.pm * BM + wr * 64 + fr;
        if (u.pn < 16) {
            const int ch0 = (u.pn >> 1) * 128 + wc * 32 + fq * 8; const bool isu = (u.pn & 1) != 0;
#pragma unroll
            for (int ai = 0; ai < 2; ++ai)
#pragma unroll
                for (int m = 0; m < 4; ++m) {
                    const int row = row0 + ai * HALF + m * 16;
                    const float rsv = rs[row];
                    const f32x4 a0 = acc[ai][0][m][0] * rsv, a1 = acc[ai][0][m][1] * rsv, b0 = acc[ai][1][m][0] * rsv, b1 = acc[ai][1][m][1] * rsv;
                    f32x4 r0, r1;
                    if (isu) { r0 = a0 * b0; r1 = a1 * b1; }
                    else {
#pragma unroll
                        for (int j = 0; j < 4; ++j) { r0[j] = a0[j] * sigmoidf_(b0[j]); r1[j] = a1[j] * sigmoidf_(b1[j]); } }
                    u32x4 w; w.x = pk2(r0[0], r0[1]); w.y = pk2(r0[2], r0[3]); w.z = pk2(r1[0], r1[1]); w.w = pk2(r1[2], r1[3]);
                    *(u32x4*)((isu ? U : S1) + (size_t)row * DM + ch0) = w;
                    if (isu) {
                        if (row < TP) { const int tpos = row & (SEQ - 1), bl = row >> 11; if (tpos >= SEQ - 2) { float* cp = convp + (size_t)(bl * 2 + tpos - (SEQ - 2)) * DM + ch0; *(f32x4*)cp = r0; *(f32x4*)(cp + 4) = r1; } }
                        else { const int r2 = row - TP, tpos = r2 & (DSEQ - 1), bl = r2 >> 6; if (tpos >= DSEQ - 2) { float* cp = convs + (size_t)(bl * 2 + tpos - (DSEQ - 2)) * DM + ch0; *(f32x4*)cp = r0; *(f32x4*)(cp + 4) = r1; } }
                    }
                }
        } else {
            const bool gate = u.pn < 20;
            bf16_t* base = gate ? GBS : ZS; const int ld = gate ? DM : ZSW;
            const int col0 = (gate ? (u.pn - 16) : (u.pn - 20)) * 256 + wc * 32 + fq * 8;
#pragma unroll
            for (int ai = 0; ai < 2; ++ai)
#pragma unroll
                for (int m = 0; m < 4; ++m) { bf16_t* rowp = base + (size_t)(row0 + ai * HALF + m * 16) * ld + col0; const float rsv = rs[row0 + ai * HALF + m * 16];
#pragma unroll
                    for (int bj = 0; bj < 2; ++bj) { f32x4 v0 = acc[ai][bj][m][0] * rsv, v1 = acc[ai][bj][m][1] * rsv;
                        if (gate) {
#pragma unroll
                            for (int j = 0; j < 4; ++j) { v0[j] = sigmoidf_(v0[j]); v1[j] = sigmoidf_(v1[j]); } }
                        u32x4 w; w.x = pk2(v0[0], v0[1]); w.y = pk2(v0[2], v0[3]); w.z = pk2(v1[0], v1[1]); w.w = pk2(v1[2], v1[3]); *(u32x4*)(rowp + bj * HALF) = w; } }
        }
    }
};

struct EpiQ {
    static constexpr bool PERM = true, AFTER_DRAIN = false;
    bf16_t* Q; const f32x2* rope;
    __device__ __forceinline__ void operator()(const f32x4 (&acc)[2][2][4][2], const Unit& u, int wr, int wc, int fr, int fq) const {
        const int row0 = u.pm * BM + wr * 64 + fr;
        if (u.pn < 4) {
            bf16_t* base = Q + (size_t)row0 * NQ + (2 * u.pn) * QKD + wc * 32 + fq * 8;
#pragma unroll
            for (int ai = 0; ai < 2; ++ai)
#pragma unroll
                for (int m = 0; m < 4; ++m) { bf16_t* rowp = base + (size_t)(ai * HALF + m * 16) * NQ;
#pragma unroll
                    for (int bj = 0; bj < 2; ++bj) { const f32x4 v0 = acc[ai][bj][m][0] * QSCALE, v1 = acc[ai][bj][m][1] * QSCALE;
                        u32x4 w; w.x = pk2(v0[0], v0[1]); w.y = pk2(v0[2], v0[3]); w.z = pk2(v1[0], v1[1]); w.w = pk2(v1[2], v1[3]);
                        *(u32x4*)(rowp + bj * QKD) = w; } }
        } else {
            const int head = (u.pn - 4) * 4 + wc;
            bf16_t* base = Q + (size_t)row0 * NQ + head * QKD + 128 + fq * 8;
#pragma unroll
            for (int ai = 0; ai < 2; ++ai)
#pragma unroll
                for (int m = 0; m < 4; ++m) { const int row = row0 + ai * HALF + m * 16; const int pos = row_pos(row);
                    const f32x2* rp = rope + pos * 32 + fq * 8; bf16_t* rowp = base + (size_t)(ai * HALF + m * 16) * NQ;
                    unsigned wa[4], wb[4];
#pragma unroll
                    for (int n = 0; n < 2; ++n) { const f32x4 x1 = acc[ai][0][m][n], x2 = acc[ai][1][m][n];
                        const f32x4 cs01 = *(const f32x4*)(rp + n * 4), cs23 = *(const f32x4*)(rp + n * 4 + 2);
                        const float c0 = cs01[0], s0 = cs01[1], c1 = cs01[2], s1 = cs01[3], c2 = cs23[0], s2 = cs23[1], c3 = cs23[2], s3 = cs23[3];
                        wa[2 * n] = pk2((x1[0] * c0 - x2[0] * s0) * QSCALE, (x1[1] * c1 - x2[1] * s1) * QSCALE); wa[2 * n + 1] = pk2((x1[2] * c2 - x2[2] * s2) * QSCALE, (x1[3] * c3 - x2[3] * s3) * QSCALE);
                        wb[2 * n] = pk2((x2[0] * c0 + x1[0] * s0) * QSCALE, (x2[1] * c1 + x1[1] * s1) * QSCALE); wb[2 * n + 1] = pk2((x2[2] * c2 + x1[2] * s2) * QSCALE, (x2[3] * c3 + x1[3] * s3) * QSCALE); }
                    *(u32x4*)rowp = (u32x4){wa[0], wa[1], wa[2], wa[3]}; *(u32x4*)(rowp + 32) = (u32x4){wb[0], wb[1], wb[2], wb[3]};
                    asm volatile("" ::: "memory"); }
        }
    }
};

template <class Epi, class Sched, bool ALIGN_EPI = false, bool SP2 = false>
__device__ __forceinline__ void gemm_phase(PG8_LAS unsigned char* lds, const Gemm g, const Sched& S, const Epi& E) {
    int tid_ = threadIdx.x; asm volatile("" : "+v"(tid_));
    const int tid = tid_, wid = __builtin_amdgcn_readfirstlane(tid >> 6), lane = tid & 63, wr = wid >> 2, wc = wid & 3, fr = lane & 15, fq = lane >> 4;
    const int K = g.K, nt = K / BK;
    unsigned voffA[2], voffB[2];
#pragma unroll
    for (int i = 0; i < 2; ++i) { int R, C; stage_rc(tid * 16 + i * 8192, R, C); const int Rb = Epi::PERM ? ((R & ~31) + perm32(R & 31)) : R;
        voffA[i] = (unsigned)(R * g.lda + C) * 2u; voffB[i] = (unsigned)(Rb * g.ldb + C) * 2u; }
    const size_t kstep = (size_t)(BK * 2);
    const size_t hstepA = (size_t)HALF * g.lda * 2, hstepB = (size_t)HALF * g.ldb * 2;
    const size_t tstepA = 2 * hstepA, tstepB = 2 * hstepB, ksl = (size_t)K * 2;
    const unsigned ldsw = (unsigned)wid * 1024u;
    const int aoff = lds_byte(wr * 64 + fr, fq * 8), boff = lds_byte(wc * 32 + fr, fq * 8);
#define PG8_SA(b, h) (((b) * 2 + (h)) * HTB)
#define PG8_SB(b, h) ((4 + (b) * 2 + (h)) * HTB)
#define PG8_STAGE(bufoff, gbase, voff) do { _Pragma("unroll") for (int _i = 0; _i < 2; ++_i) \
        __builtin_amdgcn_global_load_lds((const unsigned*)((const char*)(gbase) + (voff)[_i]), (PG8_LAS unsigned*)(lds + (bufoff) + ldsw + _i * 8192), 16, 0, 0); } while (0)
#define PG8_LDA(dst, b, h) do { _Pragma("unroll") for (int m = 0; m < 4; ++m) _Pragma("unroll") for (int k = 0; k < 2; ++k) dst[m][k] = *(const PG8_LAS bf16x8*)(lds + PG8_SA(b, h) + aoff + m * 2048 + k * 1024); } while (0)
#define PG8_LDB(dst, b, h) do { _Pragma("unroll") for (int n = 0; n < 2; ++n) _Pragma("unroll") for (int k = 0; k < 2; ++k) dst[n][k] = *(const PG8_LAS bf16x8*)(lds + PG8_SB(b, h) + boff + n * 2048 + k * 1024); } while (0)
#define PG8_MMA(ai, bj, At, Bt) do { __builtin_amdgcn_s_setprio(1); _Pragma("unroll") for (int m = 0; m < 4; ++m) _Pragma("unroll") for (int n = 0; n < 2; ++n) _Pragma("unroll") for (int k = 0; k < 2; ++k) \
        acc[ai][bj][m][n] = __builtin_amdgcn_mfma_f32_16x16x32_bf16(Bt[n][k], At[m][k], acc[ai][bj][m][n], 0, 0, 0); __builtin_amdgcn_s_setprio(0); } while (0)
#define PG8_WAIT_V(n) asm volatile("s_waitcnt vmcnt(" #n ")" ::: "memory")
#define PG8_WAIT_L(n) asm volatile("s_waitcnt lgkmcnt(" #n ")" ::: "memory")
#define PG8_BAR __builtin_amdgcn_s_barrier()
#define PG8_SCHED __builtin_amdgcn_sched_barrier(0)
    Unit cur, nxt; int ui = 0;
    if (!S.next(0, cur)) return;
    f32x4 acc[2][2][4][2];
#pragma unroll
    for (int a = 0; a < 2; ++a)
#pragma unroll
        for (int b = 0; b < 2; ++b)
#pragma unroll
            for (int m = 0; m < 4; ++m)
#pragma unroll
                for (int n = 0; n < 2; ++n) acc[a][b][m][n] = (f32x4){0.f, 0.f, 0.f, 0.f};
    bf16x8 At[4][2], B0[2][2], B1[2][2];
    const char* cA = (const char*)g.A + (size_t)cur.pm * tstepA + (size_t)cur.ks * ksl; const char* cB = (const char*)g.Bt + (size_t)cur.pn * tstepB + (size_t)cur.ks * ksl;
    S.a_ready(cur);
    if constexpr (SP2) {
        PG8_STAGE(PG8_SB(0, 0), cB, voffB); PG8_STAGE(PG8_SB(0, 1), cB + hstepB, voffB); PG8_STAGE(PG8_SA(0, 0), cA, voffA); PG8_STAGE(PG8_SA(0, 1), cA + hstepA, voffA);
        if (wr == 1) PG8_BAR;
        PG8_WAIT_V(2); PG8_BAR;
        PG8_STAGE(PG8_SB(1, 0), cB + kstep, voffB); PG8_STAGE(PG8_SA(1, 0), cA + kstep, voffA); PG8_STAGE(PG8_SB(1, 1), cB + hstepB + kstep, voffB);
        PG8_WAIT_V(6); PG8_BAR;
    } else {
        PG8_STAGE(PG8_SB(0, 0), cB, voffB); PG8_STAGE(PG8_SA(0, 0), cA, voffA); PG8_STAGE(PG8_SB(0, 1), cB + hstepB, voffB); PG8_STAGE(PG8_SA(0, 1), cA + hstepA, voffA);
        if (wr == 1) PG8_BAR;
        PG8_WAIT_V(4); PG8_BAR;
        PG8_STAGE(PG8_SB(1, 0), cB + kstep, voffB); PG8_STAGE(PG8_SA(1, 0), cA + kstep, voffA); PG8_STAGE(PG8_SB(1, 1), cB + hstepB + kstep, voffB);
        PG8_WAIT_V(6); PG8_BAR;
    }
    for (;;) {
        const bool has_next = S.next(ui + 1, nxt);
        const char* nA = has_next ? (const char*)g.A + (size_t)nxt.pm * tstepA + (size_t)nxt.ks * ksl : cA; const char* nB = has_next ? (const char*)g.Bt + (size_t)nxt.pn * tstepB + (size_t)nxt.ks * ksl : cB;
        for (int t = 0; t < nt; t += 2) {
            const bool last = (t == nt - 2);
            const char* a1 = cA + (size_t)(t + 1) * kstep;
            const char* a2 = last ? nA : cA + (size_t)(t + 2) * kstep; const char* b2 = last ? nB : cB + (size_t)(t + 2) * kstep;
            const char* a3 = a2 + kstep; const char* b3 = b2 + kstep;
            if (last && has_next) S.a_ready(nxt);
            if constexpr (SP2) {
            PG8_LDB(B0, 0, 0); PG8_LDB(B1, 0, 1); PG8_SCHED; PG8_LDA(At, 0, 0); PG8_STAGE(PG8_SA(1, 1), a1 + hstepA, voffA);
            PG8_WAIT_V(8); PG8_WAIT_L(0); PG8_BAR; PG8_MMA(0, 0, At, B0); PG8_MMA(0, 1, At, B1); PG8_BAR; PG8_SCHED;
            PG8_LDA(At, 0, 1); PG8_STAGE(PG8_SB(0, 0), b2, voffB); PG8_STAGE(PG8_SB(0, 1), b2 + hstepB, voffB); PG8_STAGE(PG8_SA(0, 0), a2, voffA);
            PG8_WAIT_V(8); PG8_WAIT_L(0); PG8_BAR; PG8_MMA(1, 0, At, B0); PG8_MMA(1, 1, At, B1); PG8_BAR; PG8_SCHED;
            PG8_LDB(B0, 1, 0); PG8_LDB(B1, 1, 1); PG8_SCHED; PG8_LDA(At, 1, 0); PG8_STAGE(PG8_SA(0, 1), a2 + hstepA, voffA);
            PG8_WAIT_V(8); PG8_WAIT_L(0); PG8_BAR; PG8_MMA(0, 0, At, B0); PG8_MMA(0, 1, At, B1); PG8_BAR; PG8_SCHED;
            PG8_LDA(At, 1, 1); PG8_STAGE(PG8_SB(1, 0), b3, voffB); PG8_STAGE(PG8_SB(1, 1), b3 + hstepB, voffB); PG8_STAGE(PG8_SA(1, 0), a3, voffA);
            PG8_WAIT_V(8); PG8_WAIT_L(0); PG8_BAR; PG8_MMA(1, 0, At, B0); PG8_MMA(1, 1, At, B1); PG8_BAR; PG8_SCHED;
            } else {
            PG8_LDB(B0, 0, 0); PG8_SCHED; PG8_LDA(At, 0, 0); PG8_STAGE(PG8_SA(1, 1), a1 + hstepA, voffA);
            PG8_WAIT_L(8); PG8_BAR; PG8_WAIT_L(0); PG8_MMA(0, 0, At, B0); PG8_BAR; PG8_SCHED;
            PG8_LDB(B1, 0, 1); PG8_STAGE(PG8_SB(0, 0), b2, voffB);
            PG8_BAR; PG8_WAIT_L(0); PG8_MMA(0, 1, At, B1); PG8_BAR;
            PG8_LDA(At, 0, 1); PG8_STAGE(PG8_SA(0, 0), a2, voffA);
            PG8_BAR; PG8_WAIT_L(0); PG8_MMA(1, 0, At, B0); PG8_BAR; PG8_SCHED;
            PG8_STAGE(PG8_SB(0, 1), b2 + hstepB, voffB);
            PG8_WAIT_V(6); PG8_BAR; PG8_MMA(1, 1, At, B1); PG8_BAR;
            PG8_LDB(B0, 1, 0); PG8_SCHED; PG8_LDA(At, 1, 0); PG8_STAGE(PG8_SA(0, 1), a2 + hstepA, voffA);
            PG8_WAIT_L(8); PG8_BAR; PG8_WAIT_L(0); PG8_MMA(0, 0, At, B0); PG8_BAR; PG8_SCHED;
            PG8_LDB(B1, 1, 1); PG8_STAGE(PG8_SB(1, 0), b3, voffB);
            PG8_BAR; PG8_WAIT_L(0); PG8_MMA(0, 1, At, B1); PG8_BAR;
            PG8_LDA(At, 1, 1); PG8_STAGE(PG8_SA(1, 0), a3, voffA);
            PG8_BAR; PG8_WAIT_L(0); PG8_MMA(1, 0, At, B0); PG8_BAR; PG8_SCHED;
            PG8_STAGE(PG8_SB(1, 1), b3 + hstepB, voffB);
            PG8_WAIT_V(6); PG8_BAR; PG8_MMA(1, 1, At, B1); PG8_BAR;
            }
        }
        if constexpr (ALIGN_EPI) { if (wr == 0) PG8_BAR; }
        if constexpr (!Epi::AFTER_DRAIN) { int t2_ = threadIdx.x; asm volatile("" : "+v"(t2_)); const int fr2 = t2_ & 15, fq2 = (t2_ >> 4) & 3;
            E(acc, cur, wr, wc, fr2, fq2); S.done(cur); }
        if (!has_next) break;
#pragma unroll
        for (int a = 0; a < 2; ++a)
#pragma unroll
            for (int b = 0; b < 2; ++b)
#pragma unroll
                for (int m = 0; m < 4; ++m)
#pragma unroll
                    for (int n = 0; n < 2; ++n) acc[a][b][m][n] = (f32x4){0.f, 0.f, 0.f, 0.f};
        cur = nxt; cA = nA; cB = nB; ++ui;
        if constexpr (ALIGN_EPI) { if (wr == 1) PG8_BAR; }
    }
    PG8_WAIT_V(0);
    if constexpr (!ALIGN_EPI) { if (wr == 0) PG8_BAR; }
    PG8_BAR;
#undef PG8_SA
#undef PG8_SB
#undef PG8_STAGE
#undef PG8_LDA
#undef PG8_LDB
#undef PG8_MMA
#undef PG8_WAIT_V
#undef PG8_WAIT_L
#undef PG8_BAR
#undef PG8_SCHED
}
}

namespace att {
constexpr int KP = 400, VP = 136, KBUF = 64 * KP, VBUF = 128 * VP;
constexpr int OFF_K = 0, OFF_V = 2 * KBUF, OFF_SCR = 2 * KBUF + 2 * VBUF, LDS_NEED = OFF_SCR + 8 * 256;
constexpr int OSTG = 32 * 272;
static_assert(8 * OSTG <= OFF_SCR && LDS_NEED <= 131072, "attention LDS map");
struct Tensors { const bf16_t *Q, *KN, *KPE, *VT, *S1, *U, *GBS; bf16_t* XN; const float* convw; const float* state; };
__device__ __forceinline__ int crow(int r, int hi) { return (r & 3) + 8 * (r >> 2) + 4 * hi; }
#define MFMA32(a, b, c) __builtin_amdgcn_mfma_f32_32x32x16_bf16((a), (b), (c), 0, 0, 0)

__device__ __forceinline__ void unit(LAS unsigned char* lds, const Tensors& T, int h, int qrow0, int nact, bool sample, int limbase, int kv0, int kvnew, int nt) {
    int tid_ = threadIdx.x; asm volatile("" : "+v"(tid_));
    const int tid = tid_, lane = tid & 63, r32 = lane & 31, hi = lane >> 5; const int wid = __builtin_amdgcn_readfirstlane(tid >> 6);
    const bool active = wid < nact;
    const int lim = sample ? limbase : limbase + (wid >> 1);
    const char* kb[3]; int ks[3]; unsigned kd[3];
#pragma unroll
    for (int i = 0; i < 3; ++i) { const int c = tid + 512 * i, row = c / 24, cc = c % 24;
        if (cc < 16) { kb[i] = (const char*)T.KN + ((size_t)row * DM + h * 128 + cc * 8) * 2; ks[i] = DM * 2; }
        else { kb[i] = (const char*)T.KPE + ((size_t)row * 64 + (cc - 16) * 8) * 2; ks[i] = 64 * 2; }
        kd[i] = (unsigned)(row * KP + cc * 16); }
    const char* vb[2]; unsigned vd[2];
#pragma unroll
    for (int i = 0; i < 2; ++i) { const int c = tid + 512 * i, drow = c >> 3, cc = c & 7;
        vb[i] = (const char*)T.VT + ((size_t)(h * 128 + drow) * TA + cc * 8) * 2; vd[i] = (unsigned)(drow * VP + cc * 16); }
    u32x4 kreg[3], vreg[2];
#define ATT_ISSUE(t) do { const int trow_ = (sample && (t) == 32) ? kvnew : kv0 + 64 * (t); \
        _Pragma("unroll") for (int i_ = 0; i_ < 3; ++i_) kreg[i_] = *(const GAS u32x4*)(kb[i_] + (size_t)trow_ * ks[i_]); \
        _Pragma("unroll") for (int i_ = 0; i_ < 2; ++i_) vreg[i_] = *(const GAS u32x4*)(vb[i_] + (size_t)trow_ * 2); } while (0)
#define ATT_WRITE(buf) do { _Pragma("unroll") for (int i_ = 0; i_ < 3; ++i_) *(LAS u32x4*)(lds + OFF_K + (buf) * KBUF + kd[i_]) = kreg[i_]; \
        _Pragma("unroll") for (int i_ = 0; i_ < 2; ++i_) { LAS u32x2* d_ = (LAS u32x2*)(lds + OFF_V + (buf) * VBUF + vd[i_]); d_[0] = (u32x2){vreg[i_].x, vreg[i_].y}; d_[1] = (u32x2){vreg[i_].z, vreg[i_].w}; } } while (0)
    ATT_ISSUE(0);
    bf16x8 qf[12];
    { const bf16_t* qrow = T.Q + (size_t)(qrow0 + 32 * (active ? wid : 0) + r32) * NQ + h * QKD + hi * 8;
#pragma unroll
      for (int d0 = 0; d0 < 12; ++d0) qf[d0] = *(const GAS bf16x8*)(qrow + d0 * 16); }
    float mrun = -1e30f, lrun = 0.f;
    f32x16 o[4];
#pragma unroll
    for (int d = 0; d < 4; ++d)
#pragma unroll
        for (int r = 0; r < 16; ++r) o[d][r] = 0.f;
    LAS float* scr = (LAS float*)(lds + OFF_SCR + wid * 256);
    ATT_WRITE(0);
    __syncthreads();
    for (int t = 0; t < nt; ++t) {
        const int buf = t & 1;
        if (t + 1 < nt) ATT_ISSUE(t + 1);
        if (active && t <= lim) {
            const LAS unsigned char* kp = lds + OFF_K + buf * KBUF + r32 * KP + hi * 16;
            f32x16 p0, p1;
#pragma unroll
            for (int r = 0; r < 16; ++r) { p0[r] = 0.f; p1[r] = 0.f; }
            { bf16x8 kf[2][4];
#pragma unroll
              for (int i = 0; i < 2; ++i) { kf[0][2 * i] = *(const LAS bf16x8*)(kp + i * 32); kf[0][2 * i + 1] = *(const LAS bf16x8*)(kp + 32 * KP + i * 32); }
#pragma unroll
              for (int b = 0; b < 6; ++b) {
                  if (b < 5) {
#pragma unroll
                      for (int i = 0; i < 2; ++i) { kf[(b + 1) & 1][2 * i] = *(const LAS bf16x8*)(kp + (2 * (b + 1) + i) * 32); kf[(b + 1) & 1][2 * i + 1] = *(const LAS bf16x8*)(kp + 32 * KP + (2 * (b + 1) + i) * 32); } }
                  __builtin_amdgcn_sched_barrier(0);
#pragma unroll
                  for (int i = 0; i < 2; ++i) { p0 = MFMA32(kf[b & 1][2 * i], qf[2 * b + i], p0); p1 = MFMA32(kf[b & 1][2 * i + 1], qf[2 * b + i], p1); }
                  __builtin_amdgcn_sched_barrier(0);
              } }
            float rm = fmaxf(p0[0], p1[0]);
#pragma unroll
            for (int r = 1; r < 16; ++r) rm = fmaxf(rm, fmaxf(p0[r], p1[r]));
            { const auto rr = __builtin_amdgcn_permlane32_swap(__float_as_uint(rm), __float_as_uint(rm), false, false);
              rm = fmaxf(__uint_as_float(rr[0]), __uint_as_float(rr[1])); }
            const bool need = rm > mrun + 8.0f;
            if (__builtin_amdgcn_ballot_w64(need) != 0ull) {
                const float mn = need ? rm : mrun; const float alpha = __builtin_amdgcn_exp2f(mrun - mn); mrun = mn; lrun *= alpha;
                if (hi == 0) scr[r32] = alpha;
                asm volatile("s_waitcnt lgkmcnt(0)" ::: "memory");
#pragma unroll
                for (int r = 0; r < 16; ++r) { const float f = scr[crow(r, hi)];
#pragma unroll
                    for (int d = 0; d < 4; ++d) o[d][r] *= f; }
                asm volatile("s_waitcnt lgkmcnt(0)" ::: "memory");
            }
#define ATT_EXP(V_, I_) do { V_[I_] = __builtin_amdgcn_exp2f(V_[I_] - mrun); ps += V_[I_]; } while (0)
            float ps = 0.f;
#pragma unroll
            for (int e = 0; e < 8; ++e) ATT_EXP(p0, e);
            const LAS unsigned char* vp = lds + OFF_V + buf * VBUF + r32 * VP + hi * 8;
            { u32x2 vf[2][8];
#pragma unroll
              for (int d = 0; d < 4; ++d) { vf[0][2 * d] = *(const LAS u32x2*)(vp + d * 32 * VP); vf[0][2 * d + 1] = *(const LAS u32x2*)(vp + d * 32 * VP + 16); }
#pragma unroll
              for (int j = 0; j < 4; ++j) {
                  if (j < 3) {
#pragma unroll
                      for (int d = 0; d < 4; ++d) { vf[(j + 1) & 1][2 * d] = *(const LAS u32x2*)(vp + d * 32 * VP + (j + 1) * 32); vf[(j + 1) & 1][2 * d + 1] = *(const LAS u32x2*)(vp + d * 32 * VP + (j + 1) * 32 + 16); } }
                  u32x4 pw;
                  if (j == 0) { pw.x = pk2(p0[0], p0[1]); pw.y = pk2(p0[2], p0[3]); pw.z = pk2(p0[4], p0[5]); pw.w = pk2(p0[6], p0[7]); }
                  else if (j == 1) { pw.x = pk2(p0[8], p0[9]); pw.y = pk2(p0[10], p0[11]); pw.z = pk2(p0[12], p0[13]); pw.w = pk2(p0[14], p0[15]); }
                  else if (j == 2) { pw.x = pk2(p1[0], p1[1]); pw.y = pk2(p1[2], p1[3]); pw.z = pk2(p1[4], p1[5]); pw.w = pk2(p1[6], p1[7]); }
                  else { pw.x = pk2(p1[8], p1[9]); pw.y = pk2(p1[10], p1[11]); pw.z = pk2(p1[12], p1[13]); pw.w = pk2(p1[14], p1[15]); }
                  const bf16x8 pa = __builtin_bit_cast(bf16x8, pw);
                  __builtin_amdgcn_sched_barrier(0);
#pragma unroll
                  for (int d = 0; d < 4; ++d) { const u32x4 bw = {vf[j & 1][2 * d].x, vf[j & 1][2 * d].y, vf[j & 1][2 * d + 1].x, vf[j & 1][2 * d + 1].y};
                      o[d] = MFMA32(pa, __builtin_bit_cast(bf16x8, bw), o[d]);
                      if (j == 0) { ATT_EXP(p0, 8 + 2 * d); ATT_EXP(p0, 9 + 2 * d); }
                      else if (j == 1) { ATT_EXP(p1, 2 * d); ATT_EXP(p1, 1 + 2 * d); }
                      else if (j == 2) { ATT_EXP(p1, 8 + 2 * d); ATT_EXP(p1, 9 + 2 * d); }
                      __builtin_amdgcn_sched_barrier(0); }
              } }
            lrun += ps;
#undef ATT_EXP
        }
        if (t + 1 < nt) ATT_WRITE(buf ^ 1);
        __syncthreads();
    }
    if (active) {
        lrun += __shfl_xor(lrun, 32);
        if (hi == 0) scr[r32] = __builtin_amdgcn_rcpf(lrun);
        asm volatile("s_waitcnt lgkmcnt(0)" ::: "memory");
        LAS unsigned char* stg = lds + wid * OSTG;
#pragma unroll
        for (int r = 0; r < 16; ++r) { const int q = crow(r, hi); const float f = scr[q];
#pragma unroll
            for (int d = 0; d < 4; ++d) *(LAS bf16_t*)(stg + q * 272 + (d * 32 + r32) * 2) = (bf16_t)(pk2(o[d][r] * f, 0.f) & 0xffffu); }
        asm volatile("s_waitcnt lgkmcnt(0)" ::: "memory");
        const int ch = lane & 15, col = h * 128 + ch * 8;
        float cw[3][8];
#pragma unroll
        for (int k = 0; k < 3; ++k) { const f32x4 a = *(const GAS f32x4*)(T.convw + k * DM + col), b = *(const GAS f32x4*)(T.convw + k * DM + col + 4);
            cw[k][0] = a[0]; cw[k][1] = a[1]; cw[k][2] = a[2]; cw[k][3] = a[3]; cw[k][4] = b[0]; cw[k][5] = b[1]; cw[k][6] = b[2]; cw[k][7] = b[3]; }
#pragma unroll 2
        for (int i = 0; i < 8; ++i) {
            const int rr = 4 * i + (lane >> 4); const int R = qrow0 + 32 * wid + rr;
            const u32x4 yw = *(const LAS u32x4*)(stg + rr * 272 + ch * 16);
            const u32x4 sw = *(const GAS u32x4*)(T.S1 + (size_t)R * DM + col), gw = *(const GAS u32x4*)(T.GBS + (size_t)R * DM + col), u0w = *(const GAS u32x4*)(T.U + (size_t)R * DM + col);
            float u1[8], u2[8];
            int tpos, bl; if (!sample) { tpos = R & (SEQ - 1); bl = 0; } else { tpos = (R - TP) & (DSEQ - 1); bl = (R - TP) >> 6; }
            if (tpos >= 1) { const u32x4 w = *(const GAS u32x4*)(T.U + (size_t)(R - 1) * DM + col);
                u1[0] = bflo(w.x); u1[1] = bfhi(w.x); u1[2] = bflo(w.y); u1[3] = bfhi(w.y); u1[4] = bflo(w.z); u1[5] = bfhi(w.z); u1[6] = bflo(w.w); u1[7] = bfhi(w.w); }
            else if (sample) { const f32x4 a = *(const GAS f32x4*)(T.state + (size_t)(bl * 2 + 1) * DM + col), b = *(const GAS f32x4*)(T.state + (size_t)(bl * 2 + 1) * DM + col + 4);
                u1[0] = a[0]; u1[1] = a[1]; u1[2] = a[2]; u1[3] = a[3]; u1[4] = b[0]; u1[5] = b[1]; u1[6] = b[2]; u1[7] = b[3]; }
            else {
#pragma unroll
                for (int e = 0; e < 8; ++e) u1[e] = 0.f; }
            if (tpos >= 2) { const u32x4 w = *(const GAS u32x4*)(T.U + (size_t)(R - 2) * DM + col);
                u2[0] = bflo(w.x); u2[1] = bfhi(w.x); u2[2] = bflo(w.y); u2[3] = bfhi(w.y); u2[4] = bflo(w.z); u2[5] = bfhi(w.z); u2[6] = bflo(w.w); u2[7] = bfhi(w.w); }
            else if (sample) { const int sr = tpos;
                const f32x4 a = *(const GAS f32x4*)(T.state + (size_t)(bl * 2 + sr) * DM + col), b = *(const GAS f32x4*)(T.state + (size_t)(bl * 2 + sr) * DM + col + 4);
                u2[0] = a[0]; u2[1] = a[1]; u2[2] = a[2]; u2[3] = a[3]; u2[4] = b[0]; u2[5] = b[1]; u2[6] = b[2]; u2[7] = b[3]; }
            else {
#pragma unroll
                for (int e = 0; e < 8; ++e) u2[e] = 0.f; }
            const unsigned yv[4] = {yw.x, yw.y, yw.z, yw.w}, sv[4] = {sw.x, sw.y, sw.z, sw.w}, gv[4] = {gw.x, gw.y, gw.z, gw.w}, uv[4] = {u0w.x, u0w.y, u0w.z, u0w.w};
            unsigned ow[4];
#pragma unroll
            for (int e = 0; e < 4; ++e) {
                const float ya = bflo(yv[e]), yb = bfhi(yv[e]), sa = bflo(sv[e]), sb = bfhi(sv[e]), ga = bflo(gv[e]), gb = bfhi(gv[e]), ua = bflo(uv[e]), ub = bfhi(uv[e]);
                const float ca = cw[0][2 * e] * u2[2 * e] + cw[1][2 * e] * u1[2 * e] + cw[2][2 * e] * ua;
                const float cb = cw[0][2 * e + 1] * u2[2 * e + 1] + cw[1][2 * e + 1] * u1[2 * e + 1] + cw[2][2 * e + 1] * ub;
                ow[e] = pk2(sa * ca + ga * ya, sb * cb + gb * yb);
            }
            *(GAS u32x4*)(T.XN + (size_t)R * DM + col) = (u32x4){ow[0], ow[1], ow[2], ow[3]};
        }
    }
    __syncthreads();
#undef ATT_ISSUE
#undef ATT_WRITE
}
}

#define XB_TMO      128
#define XB_XCNT(j)  (256  + 64 * (j))
#define XB_XSUB(j)  (1280 + 64 * (j))
#define XB_XGEN(j)  (2304 + 64 * (j))
#define XB_TOP      3328
#define XB_TOPGEN   3392
#define XCD_BAR_WORDS 3456
#define XB_SPIN_CAP (1u << 20)
__device__ __forceinline__ unsigned xb_ld(unsigned* p)              { return __hip_atomic_load(p, __ATOMIC_RELAXED, __HIP_MEMORY_SCOPE_AGENT); }
__device__ __forceinline__ unsigned xb_add(unsigned* p, unsigned v) { return __hip_atomic_fetch_add(p, v, __ATOMIC_RELAXED, __HIP_MEMORY_SCOPE_AGENT); }
__device__ __forceinline__ unsigned xb_xcc_id() { return (unsigned)__builtin_amdgcn_s_getreg((3 << 11) | 20) & 0xFu; }
#define XB_SPIN(cond, bar) do { unsigned _sp = 0; while (cond) { __builtin_amdgcn_s_sleep(1); \
    if ((++_sp & 255u) == 0u) { if (xb_ld(&(bar)[XB_TMO])) break; if (_sp > XB_SPIN_CAP) { atomicAdd(&(bar)[XB_TMO], 1u); break; } } } } while (0)
struct XcdBarrier { unsigned* bar; unsigned x; volatile LAS unsigned* st; };
__device__ __forceinline__ XcdBarrier xcd_barrier_post(unsigned* bar, volatile LAS unsigned* st) {
    XcdBarrier b; b.bar = bar; b.x = xb_xcc_id(); b.st = st;
    if (threadIdx.x == 0) (void)xb_add(&bar[XB_XCNT(b.x)], 1u);
    return b;
}
__device__ __forceinline__ void xcd_barrier_complete(unsigned* bar, unsigned x, unsigned& nloc, unsigned& nx) {
    const unsigned G = gridDim.x * gridDim.y * gridDim.z;
    unsigned sum, cnt, mine, sp = 0u;
    for (;;) {
        sum = 0u; cnt = 0u; mine = 0u;
#pragma unroll
        for (unsigned j = 0; j < 16; ++j) { const unsigned c = xb_ld(&bar[XB_XCNT(j)]); sum += c; cnt += (c > 0u) ? 1u : 0u; mine = (j == x) ? c : mine; }
        if (sum == G) break;
        __builtin_amdgcn_s_sleep(1);
        if ((++sp & 255u) == 0u) { if (xb_ld(&bar[XB_TMO])) break; if (sp > XB_SPIN_CAP) { atomicAdd(&bar[XB_TMO], 1u); break; } }
    }
    nloc = mine > 0u ? mine : 1u; nx = cnt > 0u ? cnt : 1u;
}
__device__ __forceinline__ void xcd_barrier(const XcdBarrier& b) {
    asm volatile("s_waitcnt vmcnt(0)" ::: "memory");
    __syncthreads();
    if (threadIdx.x == 0) {
        unsigned* bar = b.bar;
        __builtin_amdgcn_s_waitcnt(0);
        unsigned nloc = b.st[0], nx = b.st[1];
        if (nloc == 0u) { xcd_barrier_complete(bar, b.x, nloc, nx); b.st[0] = nloc; b.st[1] = nx; }
        const unsigned old = xb_add(&bar[XB_XSUB(b.x)], 1u);
        const unsigned gen = old / nloc;
        if (old + 1u == (gen + 1u) * nloc) {
            __builtin_amdgcn_fence(__ATOMIC_RELEASE, "agent");
            asm volatile("s_waitcnt vmcnt(0)" ::: "memory");
            const unsigned og = xb_add(&bar[XB_TOP], 1u);
            const unsigned tg = og / nx;
            if (og + 1u == (tg + 1u) * nx) xb_add(&bar[XB_TOPGEN], 1u);
            else XB_SPIN(xb_ld(&bar[XB_TOPGEN]) == tg, bar);
            __builtin_amdgcn_fence(__ATOMIC_ACQUIRE, "agent");
            xb_add(&bar[XB_XGEN(b.x)], 1u);
            asm volatile("s_waitcnt vmcnt(0)" ::: "memory");
        } else {
            XB_SPIN(xb_ld(&bar[XB_XGEN(b.x)]) == gen, bar);
            __builtin_amdgcn_fence(__ATOMIC_ACQUIRE, "agent");
            asm volatile("s_waitcnt vmcnt(0)" ::: "memory");
        }
    }
    __syncthreads();
}

constexpr int NWAVES = 8;
constexpr int LDS_BYTES = 147456;
constexpr size_t al256(size_t x) { return (x + 255) & ~(size_t)255; }
constexpr size_t W_WIN = (size_t)NWIN * DM * 2, W_UQ = (size_t)NQ * QL * 2, W_UK = (size_t)1024 * KVL * 2, W_UV = W_UK, W_O = (size_t)DM * DM * 2, W_1 = (size_t)DFF * DM * 2, W_2 = W_1;
constexpr size_t WL_WIN = 0, WL_UQ = WL_WIN + W_WIN, WL_UK = WL_UQ + W_UQ, WL_UV = WL_UK + W_UK, WL_O = WL_UV + W_UV, WL_1 = WL_O + W_O, WL_2 = WL_1 + W_1, WL_SIZE = WL_2 + W_2;
constexpr size_t WS_CTL = 0, CTL_BYTES = 16384;
constexpr size_t WS_ROPE = CTL_BYTES;
constexpr size_t WS_WB = al256(WS_ROPE + (size_t)NPOS * 32 * 8);
constexpr size_t WS_XN = al256(WS_WB + (size_t)DEPTH * WL_SIZE);
constexpr size_t WS_RSA = al256(WS_XN + (size_t)TG * DM * 2);
constexpr size_t WS_MG = al256(WS_RSA + (size_t)TG * 4);
constexpr size_t WS_OUT = al256(WS_MG + (size_t)TG * DM * 2);
constexpr size_t WS_CKVA = al256(WS_OUT + (size_t)TG * DM * 2);
constexpr size_t WS_KPEA = al256(WS_CKVA + (size_t)TA * KVL * 2);
constexpr size_t WS_Q = al256(WS_KPEA + (size_t)TA * 64 * 2);
constexpr size_t WS_KNA = al256(WS_Q + (size_t)TG * NQ * 2);
constexpr size_t WS_VTA = al256(WS_KNA + (size_t)TA * DM * 2);
constexpr size_t WS_S1 = al256(WS_VTA + (size_t)TA * DM * 2);
constexpr size_t WS_U = al256(WS_S1 + (size_t)TG * DM * 2);
constexpr size_t WS_GBS = al256(WS_U + (size_t)TG * DM * 2);
constexpr size_t WS_ZS = WS_OUT;
static_assert((size_t)TG * ZSW * 2 <= (size_t)TG * DM * 2, "ZS overlay");
constexpr size_t WS_CQN = al256(WS_GBS + (size_t)TG * DM * 2);
constexpr size_t WS_END0 = al256(WS_CQN + (size_t)TG * QL * 2);
constexpr size_t WS_PART = WS_END0;
constexpr size_t WS_END1 = al256(WS_PART + (size_t)16 * TS * DM * 4);
constexpr size_t WS_HID = WS_KNA;
static_assert(WS_HID + (size_t)TG * DFF * 2 <= WS_END0, "HID overlay");
constexpr size_t WS_END = WS_END1;

constexpr size_t O_YP = 0, O_YS = O_YP + (size_t)NBATCH * SEQ * DM, O_CKVP = O_YS + (size_t)NBATCH * DSEQ * DM, O_KPEP = O_CKVP + (size_t)DEPTH * NBATCH * SEQ * KVL,
                 O_CONVP = O_KPEP + (size_t)DEPTH * NBATCH * SEQ * 64, O_CKVS = O_CONVP + (size_t)DEPTH * NBATCH * 2 * DM, O_KPES = O_CKVS + (size_t)DEPTH * NBATCH * DSEQ * KVL,
                 O_CONVS = O_KPES + (size_t)DEPTH * NBATCH * DSEQ * 64, O_END = O_CONVS + (size_t)DEPTH * NBATCH * 2 * DM;

struct Args { const float* in[19]; float* out; unsigned char* ws; int ph_lo, ph_hi; };

__device__ __forceinline__ int srccol(int kind, int r) {
    if (kind == 0) {
        const int tile = r >> 8, lr = r & 255;
        if (tile < 16) { const int half = lr >> 7, ch = 128 * (tile >> 1) + (lr & 127);
            return ((tile & 1) ? (half ? 2048 : 1024) : (half ? 3776 : 0)) + ch; }
        if (tile < 20) return 4800 + (tile - 16) * 256 + lr;
        const int c = (tile - 20) * 256 + lr; return c < 704 ? 3072 + c : -1;
    }
    if (kind == 1) {
        const int tile = r >> 8, lr = r & 255;
        if (tile < 4) { const int head = r >> 7, d = r & 127; return head * QKD + d; }
        const int bj = lr >> 7, c = lr & 127, hl = c >> 5, i = c & 31; return ((tile - 4) * 4 + hl) * QKD + 128 + 32 * bj + i;
    }
    return r;
}
__device__ __forceinline__ void transpose_item(const float* W, int K, int N, bf16_t* WT, int ndest, int kind, LAS float* scr, int item, int lane, const float* gk = nullptr) {
    const int nblk = ndest / 32, kb = item / nblk, nb = item % nblk, k0 = 64 * kb, n0 = 32 * nb;
    const int sc = srccol(kind, n0 + (lane & 31));
#pragma unroll
    for (int i = 0; i < 32; ++i) { const int kk = 2 * i + (lane >> 5); scr[kk * 33 + (lane & 31)] = sc >= 0 ? W[(size_t)(k0 + kk) * N + sc] * (gk ? gk[k0 + kk] : 1.0f) : 0.f; }
    asm volatile("s_waitcnt lgkmcnt(0)" ::: "memory");
    const int c = lane & 7;
#pragma unroll
    for (int j = 0; j < 4; ++j) { const int n = (lane >> 3) + 8 * j; const LAS float* s = scr + (8 * c) * 33 + n;
        u32x4 o; o.x = pk2(s[0 * 33], s[1 * 33]); o.y = pk2(s[2 * 33], s[3 * 33]); o.z = pk2(s[4 * 33], s[5 * 33]); o.w = pk2(s[6 * 33], s[7 * 33]);
        *(u32x4*)(WT + (size_t)(n0 + n) * K + k0 + 8 * c) = o; }
    asm volatile("s_waitcnt lgkmcnt(0)" ::: "memory");
}

__device__ __forceinline__ void rms_row_to_bf16(const float* xrow, const float* g, bf16_t* orow, int lane) {
    const GAS f32x4* xr = (const GAS f32x4*)xrow + lane; const GAS f32x4* gr = (const GAS f32x4*)g + lane;
    f32x4 v[4]; float s = 0.f;
#pragma unroll
    for (int j = 0; j < 4; ++j) { v[j] = xr[64 * j]; s += (v[j][0] * v[j][0] + v[j][1] * v[j][1]) + (v[j][2] * v[j][2] + v[j][3] * v[j][3]); }
    const float rs = 1.0f / sqrtf(wave_sum(s) * (1.f / DM) + EPS);
    GAS u32x2* o8 = (GAS u32x2*)orow + lane;
#pragma unroll
    for (int j = 0; j < 4; ++j) { const f32x4 gg = gr[64 * j]; u32x2 w; w.x = pk2(v[j][0] * rs * gg[0], v[j][1] * rs * gg[1]); w.y = pk2(v[j][2] * rs * gg[2], v[j][3] * rs * gg[3]); o8[64 * j] = w; }
}
template <int NSL> __device__ __forceinline__ void resid_row(const float* part, const float* xf, bf16_t* xr, float* rsp, const f32x4 (&g1v)[4], float* ydst, int lane) {
    f32x4 ov[4], xv[4]; float s = 0.f;
#pragma unroll
    for (int j = 0; j < 4; ++j) { const GAS f32x4* pr = (const GAS f32x4*)part + lane + 64 * j; f32x4 pv[NSL];
#pragma unroll
        for (int sl = 0; sl < NSL; ++sl) pv[sl] = pr[(size_t)sl * (TS * DM / 4)];
        f32x4 sacc = pv[0];
#pragma unroll
        for (int sl = 1; sl < NSL; ++sl) sacc += pv[sl];
        ov[j] = sacc;
        if (xf) xv[j] = ((const GAS f32x4*)xf + lane)[64 * j]; else { const u32x2 w = ((const GAS u32x2*)xr + lane)[64 * j]; xv[j] = (f32x4){bflo(w.x), bfhi(w.x), bflo(w.y), bfhi(w.y)}; }
        s += (ov[j][0] * ov[j][0] + ov[j][1] * ov[j][1]) + (ov[j][2] * ov[j][2] + ov[j][3] * ov[j][3]); }
    const float rs = 1.0f / sqrtf(wave_sum(s) * (1.f / DM) + EPS);
    float s2 = 0.f;
#pragma unroll
    for (int j = 0; j < 4; ++j) { xv[j] = xv[j] + ov[j] * rs * g1v[j]; s2 += (xv[j][0] * xv[j][0] + xv[j][1] * xv[j][1]) + (xv[j][2] * xv[j][2] + xv[j][3] * xv[j][3]); }
    const float rs2 = 1.0f / sqrtf(wave_sum(s2) * (1.f / DM) + EPS);
    if (lane == 0) *rsp = rs2;
#pragma unroll
    for (int j = 0; j < 4; ++j) { u32x2 w; w.x = pk2(xv[j][0], xv[j][1]); w.y = pk2(xv[j][2], xv[j][3]); ((GAS u32x2*)xr + lane)[64 * j] = w; if (ydst) ((GAS f32x4*)ydst + lane)[64 * j] = xv[j]; }
}
template <int NSL> __device__ __forceinline__ void resid_phase(const bf16_t* OUTB, const float* PART, const float* xf_p, const float* xf_s, bf16_t* XR, float* RS, const float* g1, float* y_p, float* y_s, int gw, int NGW, int lane) {
    constexpr int NB = 4;
    f32x4 g1v[4];
#pragma unroll
    for (int j = 0; j < 4; ++j) g1v[j] = ((const GAS f32x4*)g1 + lane)[64 * j];
#pragma unroll 1
    for (int R0 = gw; R0 < TP; R0 += NB * NGW) {
        f32x4 xv[NB][4]; u32x2 ow[NB][4];
        if (xf_p) {
#pragma unroll
            for (int b = 0; b < NB; ++b) { const int R = R0 + b * NGW, Rc = R < TP ? R : TP - 1;
#pragma unroll
                for (int j = 0; j < 4; ++j) { ow[b][j] = ((const GAS u32x2*)(OUTB + (size_t)Rc * DM) + lane)[64 * j]; xv[b][j] = ((const GAS f32x4*)(xf_p + (size_t)Rc * DM) + lane)[64 * j]; } }
        } else {
            u32x2 xw[NB][4];
#pragma unroll
            for (int b = 0; b < NB; ++b) { const int R = R0 + b * NGW, Rc = R < TP ? R : TP - 1;
#pragma unroll
                for (int j = 0; j < 4; ++j) { ow[b][j] = ((const GAS u32x2*)(OUTB + (size_t)Rc * DM) + lane)[64 * j]; xw[b][j] = ((const GAS u32x2*)(XR + (size_t)Rc * DM) + lane)[64 * j]; } }
#pragma unroll
            for (int b = 0; b < NB; ++b)
#pragma unroll
                for (int j = 0; j < 4; ++j) xv[b][j] = (f32x4){bflo(xw[b][j].x), bfhi(xw[b][j].x), bflo(xw[b][j].y), bfhi(xw[b][j].y)};
        }
#pragma unroll
        for (int b = 0; b < NB; ++b) { const int R = R0 + b * NGW;
            f32x4 ov[4]; float s = 0.f;
#pragma unroll
            for (int j = 0; j < 4; ++j) { const u32x2 w = ow[b][j]; ov[j] = (f32x4){bflo(w.x), bfhi(w.x), bflo(w.y), bfhi(w.y)}; s += (ov[j][0] * ov[j][0] + ov[j][1] * ov[j][1]) + (ov[j][2] * ov[j][2] + ov[j][3] * ov[j][3]); }
            const float rs = 1.0f / sqrtf(wave_sum(s) * (1.f / DM) + EPS);
            float s2 = 0.f;
#pragma unroll
            for (int j = 0; j < 4; ++j) { xv[b][j] = xv[b][j] + ov[j] * rs * g1v[j]; s2 += (xv[b][j][0] * xv[b][j][0] + xv[b][j][1] * xv[b][j][1]) + (xv[b][j][2] * xv[b][j][2] + xv[b][j][3] * xv[b][j][3]); }
            const float rs2 = 1.0f / sqrtf(wave_sum(s2) * (1.f / DM) + EPS);
            if (R < TP) {
                if (lane == 0) RS[R] = rs2;
                GAS u32x2* o8 = (GAS u32x2*)(XR + (size_t)R * DM) + lane;
#pragma unroll
                for (int j = 0; j < 4; ++j) { u32x2 w; w.x = pk2(xv[b][j][0], xv[b][j][1]); w.y = pk2(xv[b][j][2], xv[b][j][3]); o8[64 * j] = w; }
                if (y_p) { GAS f32x4* yo = (GAS f32x4*)(y_p + (size_t)R * DM) + lane;
#pragma unroll
                    for (int j = 0; j < 4; ++j) yo[64 * j] = xv[b][j]; }
            }
        }
    }
#pragma unroll 1
    for (int R = TP + gw; R < TG; R += NGW)
        resid_row<NSL>(PART + (size_t)(R - TP) * DM, xf_s ? xf_s + (size_t)(R - TP) * DM : nullptr, XR + (size_t)R * DM, RS + R, g1v, y_s ? y_s + (size_t)(R - TP) * DM : nullptr, lane);
}

constexpr int NPH_G = 1 + 9 * DEPTH, NPH = NG * NPH_G;
constexpr int NS5 = 4, NS8 = 8;

__global__ void __launch_bounds__(NWAVES * 64, 2) mega_fwd(Args a) {
    extern __shared__ __attribute__((aligned(16))) unsigned char lds_raw[];
    LAS unsigned char* lds = (LAS unsigned char*)lds_raw;
    cg::grid_group grid = cg::this_grid();
    { volatile LAS unsigned* st0 = (volatile LAS unsigned*)(lds + 131072); if (threadIdx.x < 4) st0[threadIdx.x] = 0u; __syncthreads(); }
    const XcdBarrier xbar = xcd_barrier_post((unsigned*)(a.ws + WS_CTL), (volatile LAS unsigned*)(lds + 131072));
    int ph = 0;
    const int lo = a.ph_lo, hi = a.ph_hi;
#define PH_BEGIN if (ph >= lo && ph < hi) { \
    int tid = threadIdx.x; asm volatile("" : "+v"(tid)); const int lane = tid & 63; (void)lane; const int wave = __builtin_amdgcn_readfirstlane(tid >> 6); \
    int G = gridDim.x, bx = blockIdx.x; asm volatile("" : "+s"(G), "+s"(bx)); \
    const int vcu = (G % 8 == 0) ? (bx % 8) * (G / 8) + bx / 8 : bx; const int gw = vcu * NWAVES + wave, NGW = G * NWAVES; (void)gw; (void)NGW; \
    int g = g0, l = l0; asm volatile("" : "+s"(g), "+s"(l)); (void)l; \
    unsigned char* ws = a.ws; float* out = a.out; asm volatile("" : "+s"(ws), "+s"(out)); \
    const f32x2* rope = (const f32x2*)(ws + WS_ROPE); (void)rope; \
    bf16_t* XN = (bf16_t*)(ws + WS_XN); bf16_t* OUTB = (bf16_t*)(ws + WS_OUT); bf16_t* CKVA = (bf16_t*)(ws + WS_CKVA); bf16_t* KPEA = (bf16_t*)(ws + WS_KPEA); \
    bf16_t* QB = (bf16_t*)(ws + WS_Q); bf16_t* KNA = (bf16_t*)(ws + WS_KNA); bf16_t* VTA = (bf16_t*)(ws + WS_VTA); bf16_t* S1 = (bf16_t*)(ws + WS_S1); \
    bf16_t* UB = (bf16_t*)(ws + WS_U); bf16_t* GBS = (bf16_t*)(ws + WS_GBS); bf16_t* ZS = (bf16_t*)(ws + WS_ZS); bf16_t* CQN = (bf16_t*)(ws + WS_CQN); bf16_t* HID = (bf16_t*)(ws + WS_HID); float* PART = (float*)(ws + WS_PART); (void)PART; bf16_t* MG = (bf16_t*)(ws + WS_MG); float* RSA = (float*)(ws + WS_RSA); (void)MG; (void)RSA; \
    (void)XN; (void)OUTB; (void)CKVA; (void)KPEA; (void)QB; (void)KNA; (void)VTA; (void)S1; (void)UB; (void)GBS; (void)ZS; (void)CQN; (void)HID; \
    const float* xp_in = a.in[0] + (size_t)g * TP * DM; const float* xs_in = a.in[1] + (size_t)g * TS * DM; (void)xp_in; (void)xs_in; \
    float* xp = out + O_YP + (size_t)g * TP * DM; float* xs = out + O_YS + (size_t)g * TS * DM; (void)xp; (void)xs; \
    const unsigned char* wl = ws + WS_WB + (size_t)l * WL_SIZE; (void)wl;
#define PH_END } ++ph; if (ph - 1 >= lo && ph < hi) { if (ph == 1) grid.sync(); else xcd_barrier(xbar); }

#pragma unroll 1
    for (int g0 = 0; g0 < NG; ++g0) {
        { const int l0 = 0;

        PH_BEGIN
        if (g == 0) {
            LAS float* scr = (LAS float*)(lds + wave * 16384);
            constexpr int I_WIN = (DM / 64) * (NWIN / 32), I_UQ = (QL / 64) * (NQ / 32), I_UK = (KVL / 64) * (1024 / 32), I_O = (DM / 64) * (DM / 32), I_1 = (DM / 64) * (DFF / 32), I_2 = (DFF / 64) * (DM / 32);
            constexpr int I_L = I_WIN + I_UQ + 2 * I_UK + I_O + I_1 + I_2;
            for (int it = gw; it < DEPTH * I_L; it += NGW) {
                const int ll = it / I_L; int r = it % I_L; bf16_t* wl2 = (bf16_t*)(ws + WS_WB + (size_t)ll * WL_SIZE);
                if (r < I_WIN) { transpose_item(a.in[5] + (size_t)ll * DM * DIN, DM, DIN, (bf16_t*)((char*)wl2 + WL_WIN), NWIN, 0, scr, r, lane, a.in[13] + (size_t)ll * DM); continue; } r -= I_WIN;
                if (r < I_UQ) { transpose_item(a.in[7] + (size_t)ll * QL * NQ, QL, NQ, (bf16_t*)((char*)wl2 + WL_UQ), NQ, 1, scr, r, lane); continue; } r -= I_UQ;
                if (r < I_UK) { transpose_item(a.in[8] + (size_t)ll * KVL * 1024, KVL, 1024, (bf16_t*)((char*)wl2 + WL_UK), 1024, 2, scr, r, lane); continue; } r -= I_UK;
                if (r < I_UK) { transpose_item(a.in[9] + (size_t)ll * KVL * 1024, KVL, 1024, (bf16_t*)((char*)wl2 + WL_UV), 1024, 2, scr, r, lane); continue; } r -= I_UK;
                if (r < I_O) { transpose_item(a.in[10] + (size_t)ll * DM * DM, DM, DM, (bf16_t*)((char*)wl2 + WL_O), DM, 2, scr, r, lane); continue; } r -= I_O;
                if (r < I_1) { transpose_item(a.in[11] + (size_t)ll * DM * DFF, DM, DFF, (bf16_t*)((char*)wl2 + WL_1), DFF, 2, scr, r, lane, a.in[15] + (size_t)ll * DM); continue; } r -= I_1;
                transpose_item(a.in[12] + (size_t)ll * DFF * DM, DFF, DM, (bf16_t*)((char*)wl2 + WL_2), DM, 2, scr, r, lane);
            }
            for (int idx = bx * 512 + tid; idx < NPOS * 32; idx += G * 512) {
                const int pos = idx >> 5, i = idx & 31; double inv = 1.0;
                for (int k = 0; k < i; ++k) inv *= 0.74989420933245582730;
                const float ang = (float)pos * (float)inv;
                const double rev = (double)ang * 0.15915494309189533577; const float fr = (float)(rev - __builtin_rint(rev));
                ((f32x2*)(ws + WS_ROPE))[idx] = (f32x2){__builtin_amdgcn_cosf(fr), __builtin_amdgcn_sinf(fr)};
            }
        }
        {
#pragma unroll 1
          for (int R0 = gw; R0 < TG; R0 += 4 * NGW) { f32x4 v[4][4];
#pragma unroll
              for (int b = 0; b < 4; ++b) { const int R = R0 + b * NGW, Rc = R < TG ? R : TG - 1; const float* xr = Rc < TP ? xp_in + (size_t)Rc * DM : xs_in + (size_t)(Rc - TP) * DM;
#pragma unroll
                  for (int j = 0; j < 4; ++j) v[b][j] = ((const GAS f32x4*)xr + lane)[64 * j]; }
#pragma unroll
              for (int b = 0; b < 4; ++b) { const int R = R0 + b * NGW; float sq = 0.f;
#pragma unroll
                  for (int j = 0; j < 4; ++j) sq += (v[b][j][0] * v[b][j][0] + v[b][j][1] * v[b][j][1]) + (v[b][j][2] * v[b][j][2] + v[b][j][3] * v[b][j][3]);
                  const float rs = 1.0f / sqrtf(wave_sum(sq) * (1.f / DM) + EPS);
                  if (R < TG) { GAS u32x2* o8 = (GAS u32x2*)(XN + (size_t)R * DM) + lane; if (lane == 0) RSA[R] = rs;
#pragma unroll
                      for (int j = 0; j < 4; ++j) { const f32x4 w = v[b][j]; u32x2 o; o.x = pk2(w[0], w[1]); o.y = pk2(w[2], w[3]); o8[64 * j] = o; } } } } }
        PH_END
        }
#pragma unroll 1
        for (int l0 = 0; l0 < DEPTH; ++l0) {
            PH_BEGIN
            { pg8::Gemm gm = pg8::mkgemm(XN, (const bf16_t*)(wl + WL_WIN), TG, NWIN, DM); pg8::StaticOrder S; S.init(TG, NWIN, G, bx);
              pg8::EpiWin E{S1, UB, GBS, ZS, RSA, out + O_CONVP + (size_t)(l * NBATCH + g * GB) * 2 * DM, out + O_CONVS + (size_t)(l * NBATCH + g * GB) * 2 * DM};
              pg8::gemm_phase<pg8::EpiWin, pg8::StaticOrder, true, true>(lds, gm, S, E); }
            PH_END
            PH_BEGIN
            {
                const float* gq = a.in[17] + (size_t)l * QL; const float* gkv = a.in[18] + (size_t)l * KVL;
                constexpr int NB = 4;
                f32x2 gqv[3];
#pragma unroll
                for (int j = 0; j < 3; ++j) gqv[j] = *(const GAS f32x2*)(gq + 128 * j + 2 * lane);
                const f32x4 gk = *(const GAS f32x4*)(gkv + 4 * lane);
#pragma unroll 1
                for (int R0 = gw; R0 < TG; R0 += NB * NGW) {
                    unsigned cw[NB][3]; u32x2 kw[NB]; bf16_t p1[NB], p2[NB]; f32x2 cs[NB];
#pragma unroll
                    for (int b = 0; b < NB; ++b) { const int R = R0 + b * NGW, Rc = R < TG ? R : TG - 1; const bf16_t* z = ZS + (size_t)Rc * ZSW;
#pragma unroll
                        for (int j = 0; j < 3; ++j) cw[b][j] = *(const GAS unsigned*)(z + 128 * j + 2 * lane);
                        kw[b] = *(const GAS u32x2*)(z + 384 + 4 * lane);
                        p1[b] = *(const GAS bf16_t*)(z + 640 + (lane & 31)); p2[b] = *(const GAS bf16_t*)(z + 672 + (lane & 31));
                        cs[b] = *(const GAS f32x2*)(rope + row_pos(Rc) * 32 + (lane & 31)); }
#pragma unroll
                    for (int b = 0; b < NB; ++b) { const int R = R0 + b * NGW;
                        float cq[6]; float s = 0.f;
#pragma unroll
                        for (int j = 0; j < 3; ++j) { cq[2 * j] = bflo(cw[b][j]); cq[2 * j + 1] = bfhi(cw[b][j]); s += cq[2 * j] * cq[2 * j] + cq[2 * j + 1] * cq[2 * j + 1]; }
                        const float rsq = 1.0f / sqrtf(wave_sum(s) * (1.f / QL) + EPS);
                        f32x4 kv = {bflo(kw[b].x), bfhi(kw[b].x), bflo(kw[b].y), bfhi(kw[b].y)};
                        const float rsk = 1.0f / sqrtf(wave_sum((kv[0] * kv[0] + kv[1] * kv[1]) + (kv[2] * kv[2] + kv[3] * kv[3])) * (1.f / KVL) + EPS);
                        if (R < TG) {
#pragma unroll
                            for (int j = 0; j < 3; ++j) *(GAS unsigned*)(CQN + (size_t)R * QL + 128 * j + 2 * lane) = pk2(cq[2 * j] * rsq * gqv[j][0], cq[2 * j + 1] * rsq * gqv[j][1]);
                            kv = kv * rsk * gk;
                            float* ockv = R < TP ? out + O_CKVP + ((size_t)l * NBATCH * SEQ + (size_t)g * TP + R) * KVL : out + O_CKVS + ((size_t)l * NBATCH * DSEQ + (size_t)g * TS + (R - TP)) * KVL;
                            *(GAS f32x4*)(ockv + 4 * lane) = kv;
                            u32x2 kb; kb.x = pk2(kv[0], kv[1]); kb.y = pk2(kv[2], kv[3]); *(GAS u32x2*)(CKVA + (size_t)R * KVL + 4 * lane) = kb;
                            if (lane < 32) {
                                const float x1 = __uint_as_float((unsigned)p1[b] << 16), x2 = __uint_as_float((unsigned)p2[b] << 16);
                                const float o1 = x1 * cs[b][0] - x2 * cs[b][1], o2 = x2 * cs[b][0] + x1 * cs[b][1];
                                float* okpe = R < TP ? out + O_KPEP + ((size_t)l * NBATCH * SEQ + (size_t)g * TP + R) * 64 : out + O_KPES + ((size_t)l * NBATCH * DSEQ + (size_t)g * TS + (R - TP)) * 64;
                                okpe[lane] = o1; okpe[32 + lane] = o2;
                                KPEA[(size_t)R * 64 + lane] = (bf16_t)(pk2(o1, 0.f) & 0xffffu); KPEA[(size_t)R * 64 + 32 + lane] = (bf16_t)(pk2(o2, 0.f) & 0xffffu);
                            }
                        }
                    }
                }
                const float* pc = a.in[2] + ((size_t)l * NBATCH + g * GB) * PAST * KVL; const float* pk = a.in[3] + ((size_t)l * NBATCH + g * GB) * PAST * 64;
                { const size_t nth = (size_t)G * 512, i0 = (size_t)bx * 512 + tid; constexpr size_t NC = (size_t)TPAST * KVL / 8, NK = (size_t)TPAST * 64 / 8;
#pragma unroll 1
                  for (size_t i = i0; i < NC; i += 4 * nth) { f32x4 v[4][2];
#pragma unroll
                      for (int u = 0; u < 4; ++u) { const size_t ii = i + u * nth < NC ? i + u * nth : NC - 1; v[u][0] = *(const GAS f32x4*)(pc + ii * 8); v[u][1] = *(const GAS f32x4*)(pc + ii * 8 + 4); }
#pragma unroll
                      for (int u = 0; u < 4; ++u) if (i + u * nth < NC) *(GAS u32x4*)(CKVA + (size_t)TG * KVL + (i + u * nth) * 8) = (u32x4){pk2(v[u][0][0], v[u][0][1]), pk2(v[u][0][2], v[u][0][3]), pk2(v[u][1][0], v[u][1][1]), pk2(v[u][1][2], v[u][1][3])}; }
#pragma unroll 1
                  for (size_t i = i0; i < NK; i += nth) { const f32x4 v0 = *(const GAS f32x4*)(pk + i * 8), v1 = *(const GAS f32x4*)(pk + i * 8 + 4);
                      *(GAS u32x4*)(KPEA + (size_t)TG * 64 + i * 8) = (u32x4){pk2(v0[0], v0[1]), pk2(v0[2], v0[3]), pk2(v1[0], v1[1]), pk2(v1[2], v1[3])}; } }
            }
            PH_END
            PH_BEGIN
            { { pg8::Gemm gm = pg8::mkgemm(CQN, (const bf16_t*)(wl + WL_UQ), TG, NQ, QL); pg8::StaticOrder S; S.init(TG, NQ, G, bx);
                pg8::EpiQ E{QB, rope}; pg8::gemm_phase<pg8::EpiQ, pg8::StaticOrder, true, true>(lds, gm, S, E); }
              constexpr int n1 = (TG / 256) * (NQ / 256), n2 = (TA / 256) * 4;
#pragma unroll 1
              for (int k = 0; k < 2; ++k) {
                  pg8::Gemm gm = k == 0 ? pg8::mkgemm(CKVA, (const bf16_t*)(wl + WL_UK), TA, 1024, KVL) : pg8::mkgemm((const bf16_t*)(wl + WL_UV), CKVA, 1024, TA, KVL);
                  const int off = (k == 0 ? n1 : n1 + n2) % G; pg8::StaticOrder S; S.init(gm.M, gm.N, G, (bx + G - off) % G);
                  pg8::EpiPlain<0> E{k == 0 ? KNA : VTA, k == 0 ? (long)DM : (long)TA, nullptr};
                  pg8::gemm_phase<pg8::EpiPlain<0>, pg8::StaticOrder, true, true>(lds, gm, S, E);
              } }
            PH_END
            PH_BEGIN
            { att::Tensors T{QB, KNA, KPEA, VTA, S1, UB, GBS, MG, a.in[6] + (size_t)l * 3 * DM, a.in[4] + ((size_t)l * NBATCH + g * GB) * 2 * DM};
#pragma unroll 1
              for (int i = vcu; i < 1280; i += G) {
                  const int round = i >> 8, cu = i & 255, p = cu >> 1, odd = cu & 1, bl = p >> 3, h = p & 7;
                  const int qb = odd ? (round == 0 ? 7 : round == 1 ? 5 : round == 2 ? 0 : -1) : (round == 0 ? 6 : round == 1 ? 4 : round == 2 ? 3 : round == 3 ? 2 : 1);
                  if (qb >= 0) att::unit(lds, T, h, bl * SEQ + qb * 256, 8, false, 4 * qb, bl * SEQ, 0, 4 * qb + 4);
                  else if (round == 3) att::unit(lds, T, h, TP + bl * DSEQ, 2, true, 32, TG + bl * PAST, TP + bl * DSEQ, 33);
              } }
            PH_END
            PH_BEGIN
            { { pg8::Gemm gm = pg8::mkgemm(MG, (const bf16_t*)(wl + WL_O), TP, DM, DM); pg8::StaticOrder S; S.init(TP, DM, G, bx);
                pg8::EpiPlain<0> E{OUTB, (long)DM, nullptr}; pg8::gemm_phase<pg8::EpiPlain<0>, pg8::StaticOrder, true, true>(lds, gm, S, E); }
              { pg8::Gemm gm{MG + (size_t)TP * DM, (const bf16_t*)(wl + WL_O), TS, DM, DM / NS5, DM, DM}; pg8::SplitOrder S; S.init(TS, DM, NS5, G, bx);
                pg8::EpiPartial E{PART, (long)DM, (long)TS * DM}; pg8::gemm_phase<pg8::EpiPartial, pg8::SplitOrder, true, true>(lds, gm, S, E); } }
            PH_END
            PH_BEGIN
            resid_phase<NS5>(OUTB, PART, l == 0 ? xp_in : nullptr, l == 0 ? xs_in : nullptr, XN, RSA, a.in[14] + (size_t)l * DM, nullptr, nullptr, gw, NGW, lane);
            PH_END
            PH_BEGIN
            { pg8::Gemm gm = pg8::mkgemm(XN, (const bf16_t*)(wl + WL_1), TG, DFF, DM); pg8::StaticOrder S; S.init(TG, DFF, G, bx);
              pg8::EpiPlain<1> E{HID, (long)DFF, RSA}; pg8::gemm_phase<pg8::EpiPlain<1>, pg8::StaticOrder, true, true>(lds, gm, S, E); }
            PH_END
            PH_BEGIN
            { { pg8::Gemm gm = pg8::mkgemm(HID, (const bf16_t*)(wl + WL_2), TP, DM, DFF); pg8::StaticOrder S; S.init(TP, DM, G, bx);
                pg8::EpiPlain<0> E{OUTB, (long)DM, nullptr}; pg8::gemm_phase<pg8::EpiPlain<0>, pg8::StaticOrder, true, true>(lds, gm, S, E); }
              { pg8::Gemm gm{HID + (size_t)TP * DFF, (const bf16_t*)(wl + WL_2), TS, DM, DFF / NS8, DFF, DFF}; pg8::SplitOrder S; S.init(TS, DM, NS8, G, bx);
                pg8::EpiPartial E{PART, (long)DM, (long)TS * DM}; pg8::gemm_phase<pg8::EpiPartial, pg8::SplitOrder, true, true>(lds, gm, S, E); } }
            PH_END
            PH_BEGIN
            resid_phase<NS8>(OUTB, PART, nullptr, nullptr, XN, RSA, a.in[16] + (size_t)l * DM, (l + 1 < DEPTH) ? nullptr : xp, (l + 1 < DEPTH) ? nullptr : xs, gw, NGW, lane);
            PH_END
        }
    }
#undef PH_BEGIN
#undef PH_END
}

extern "C" void kernel_launch(void* const* d_in, const int* in_sizes, int n_in, void* d_out, int out_size, void* d_ws, size_t ws_size, hipStream_t stream) {
    static int grid = 0;
    if (grid == 0) {
        if (n_in != 19 || (size_t)out_size != O_END || ws_size < WS_END) { fprintf(stderr, "kernel_launch: shape/workspace mismatch: n_in %d out %d (want %zu) ws %zu (need %zu)\n", n_in, out_size, (size_t)O_END, ws_size, (size_t)WS_END); grid = -1; return; }
        int dev = 0, cus = 0, per_cu = 0;
        if (hipGetDevice(&dev) != hipSuccess || hipDeviceGetAttribute(&cus, hipDeviceAttributeMultiprocessorCount, dev) != hipSuccess) { grid = -1; return; }
        if (hipFuncSetAttribute((const void*)mega_fwd, hipFuncAttributeMaxDynamicSharedMemorySize, LDS_BYTES) != hipSuccess) { fprintf(stderr, "kernel_launch: hipFuncSetAttribute failed\n"); grid = -1; return; }
        if (hipOccupancyMaxActiveBlocksPerMultiprocessor(&per_cu, (const void*)mega_fwd, NWAVES * 64, LDS_BYTES) != hipSuccess || per_cu < 1) { fprintf(stderr, "kernel_launch: occupancy query says %d\n", per_cu); per_cu = 1; }
        (void)hipGetLastError();
        grid = cus * 1;
    }
    if (grid < 0) return;
    if (hipMemsetAsync((char*)d_ws + WS_CTL, 0, CTL_BYTES, stream) != hipSuccess) { fprintf(stderr, "kernel_launch: memset failed\n"); return; }
    Args a{};
    for (int i = 0; i < 19; ++i) a.in[i] = (const float*)d_in[i];
    a.out = (float*)d_out; a.ws = (unsigned char*)d_ws;
#if MK_MULTI
    for (int p = 0; p < NPH; ++p) { a.ph_lo = p; a.ph_hi = p + 1; hipLaunchKernelGGL(mega_fwd, dim3(grid), dim3(NWAVES * 64), LDS_BYTES, stream, a); }
#else
    a.ph_lo = 0; a.ph_hi = NPH;
    void* args[] = {&a};
    hipError_t e = hipLaunchCooperativeKernel((const void*)mega_fwd, dim3(grid), dim3(NWAVES * 64), args, LDS_BYTES, stream);
    if (e != hipSuccess) fprintf(stderr, "kernel_launch: cooperative launch failed: %s (grid %d)\n", hipGetErrorString(e), grid);
#endif
}
```

```cpp
#include <hip/hip_runtime.h>
#include <hip/hip_cooperative_groups.h>
#include <cstdio>
#include <cstdint>
namespace cg = cooperative_groups;

#ifndef MK_MULTI
#define MK_MULTI 0
#endif

#define LAS __attribute__((address_space(3)))
#define GAS __attribute__((address_space(1)))
typedef unsigned short bf16_t;
typedef short bf16x8 __attribute__((ext_vector_type(8)));
typedef float f32x4 __attribute__((ext_vector_type(4)));
typedef float f32x2 __attribute__((ext_vector_type(2)));
typedef float f32x16 __attribute__((ext_vector_type(16)));
typedef unsigned u32x4 __attribute__((ext_vector_type(4)));
typedef unsigned u32x2 __attribute__((ext_vector_type(2)));
typedef __bf16 bf16x2_t __attribute__((ext_vector_type(2)));

constexpr int DM = 1024, NBATCH = 32, SEQ = 2048, DEPTH = 4, DSEQ = 64, PAST = 2048;
constexpr int NHEAD = 8, QKD = 192, QL = 384, KVL = 256, DFF = 4096, DIN = 5824;
constexpr int NG = 2, GB = NBATCH / NG;
constexpr int TP = GB * SEQ, TS = GB * DSEQ, TG = TP + TS, TPAST = GB * PAST, TA = TG + TPAST;
constexpr int NWIN = 5888, NQ = 1536, ZSW = 768;
constexpr int NPOS = PAST + DSEQ;
constexpr float EPS = 1e-6f;
constexpr float QSCALE = 0.07216878364870322f * 1.4426950408889634f;
static_assert(TG % 256 == 0 && TA % 256 == 0, "row tiles");

__device__ __forceinline__ unsigned pk2(float lo, float hi) { f32x2 v = {lo, hi}; bf16x2_t b = __builtin_convertvector(v, bf16x2_t); return __builtin_bit_cast(unsigned, b); }
__device__ __forceinline__ float bflo(unsigned w) { return __uint_as_float(w << 16); }
__device__ __forceinline__ float bfhi(unsigned w) { return __uint_as_float(w & 0xffff0000u); }
__device__ __forceinline__ float sigmoidf_(float x) { return __builtin_amdgcn_rcpf(1.0f + __builtin_amdgcn_exp2f(-1.4426950408889634f * x)); }
__device__ __forceinline__ float wave_sum(float v) {
#pragma unroll
    for (int o = 1; o < 64; o <<= 1) v += __shfl_xor(v, o);
    return v;
}
__device__ __forceinline__ int row_pos(int R) { return R < TP ? (R & (SEQ - 1)) : PAST + ((R - TP) & (DSEQ - 1)); }

namespace pg8 {
#define PG8_LAS __attribute__((address_space(3)))
constexpr int BM = 256, BK = 64, HALF = 128, HTB = HALF * BK * 2, STAGE_BYTES = 8 * HTB, NXCD = 8, WGM = 8;

__host__ __device__ __forceinline__ int lds_byte(int r, int c) { const int st = (r >> 4) * 2 + (c >> 5), rr = r & 15, cc = c & 31, ob = rr * 64 + cc * 2; return st * 1024 + (ob ^ (((ob >> 9) & 1) << 5)); }
__host__ __device__ __forceinline__ void stage_rc(int b, int& R, int& C) { const int st = b / 1024, sb = b % 1024, swz = sb ^ (((sb >> 9) & 1) << 5); R = (st >> 1) * 16 + swz / 64; C = (st & 1) * 32 + (swz % 64) / 2; }
__host__ __device__ __forceinline__ int perm32(int rho) { const int n = rho >> 4, i = rho & 15; return 8 * (i >> 2) + 4 * n + (i & 3); }

struct Unit { int pm, pn, ks; };
struct Gemm { const bf16_t* A; const bf16_t* Bt; int M, N, K, lda, ldb; };
__device__ __forceinline__ Gemm mkgemm(const bf16_t* A, const bf16_t* Bt, int M, int N, int K) { return Gemm{A, Bt, M, N, K, K, K}; }

struct StaticOrder {
    int nM, nN, nwg, G, c;
    __host__ __device__ void init(int M, int N, int G_, int c_) { nM = M / BM; nN = N / BM; nwg = nM * nN; G = G_; c = c_; }
    __host__ __device__ bool next(int i, Unit& u) const {
        const long L = (long)i * G + c; if (L >= nwg) return false;
        int wgid = (int)L; { const int q = nwg / NXCD, r = nwg % NXCD, xcd = wgid % NXCD, off = wgid / NXCD; wgid = (xcd < r ? xcd * (q + 1) : r * (q + 1) + (xcd - r) * q) + off; }
        const int nig = WGM * nN, gid = wgid / nig, fm = gid * WGM, gsz = (nM - fm) < WGM ? (nM - fm) : WGM;
        u.pm = fm + ((wgid % nig) % gsz); u.pn = (wgid % nig) / gsz; u.ks = 0; return true;
    }
    __device__ __forceinline__ void a_ready(const Unit&) const {}
    __device__ __forceinline__ void done(const Unit&) const {}
};

struct SplitOrder {
    int nN, nS, nwg, G, c;
    __host__ __device__ void init(int M, int N, int nS_, int G_, int c_) { nN = N / BM; nS = nS_; nwg = (M / BM) * nN * nS; G = G_; c = c_; }
    __host__ __device__ bool next(int i, Unit& u) const { const long L = (long)i * G + c; if (L >= nwg) return false; const int l = (int)L; u.ks = l % nS; const int t = l / nS; u.pn = t % nN; u.pm = t / nN; return true; }
    __device__ __forceinline__ void a_ready(const Unit&) const {}
    __device__ __forceinline__ void done(const Unit&) const {}
};

template <int ACT> struct EpiPlain {
    static constexpr bool PERM = true, AFTER_DRAIN = false;
    bf16_t* O; long ldc; const float* rs;
    __device__ __forceinline__ void operator()(const f32x4 (&acc)[2][2][4][2], const Unit& u, int wr, int wc, int fr, int fq) const {
        const int row0 = u.pm * BM + wr * 64 + fr; const int col0 = u.pn * BM + wc * 32 + 8 * fq;
#pragma unroll
        for (int ai = 0; ai < 2; ++ai)
#pragma unroll
            for (int m = 0; m < 4; ++m) { bf16_t* rowp = O + (size_t)(row0 + ai * HALF + m * 16) * ldc + col0; float rsv = 1.f; if (ACT == 1) rsv = rs[row0 + ai * HALF + m * 16];
#pragma unroll
                for (int bj = 0; bj < 2; ++bj) { f32x4 v0 = acc[ai][bj][m][0], v1 = acc[ai][bj][m][1];
                    if (ACT == 1) {
#pragma unroll
                        for (int j = 0; j < 4; ++j) { const float a = fmaxf(v0[j] * rsv, 0.f), b = fmaxf(v1[j] * rsv, 0.f); v0[j] = a * a; v1[j] = b * b; } }
                    u32x4 w; w.x = pk2(v0[0], v0[1]); w.y = pk2(v0[2], v0[3]); w.z = pk2(v1[0], v1[1]); w.w = pk2(v1[2], v1[3]);
                    *(u32x4*)(rowp + bj * HALF) = w; } }
    }
};

struct EpiPartial {
    static constexpr bool PERM = false, AFTER_DRAIN = false;
    float* P; long ldc; long sstride;
    __device__ __forceinline__ void operator()(const f32x4 (&acc)[2][2][4][2], const Unit& u, int wr, int wc, int fr, int fq) const {
        float* base = P + (size_t)u.ks * sstride + (size_t)(u.pm * BM + wr * 64 + fr) * ldc + u.pn * BM + wc * 32 + fq * 4;
#pragma unroll
        for (int ai = 0; ai < 2; ++ai)
#pragma unroll
            for (int m = 0; m < 4; ++m) { float* rowp = base + (size_t)(ai * HALF + m * 16) * ldc;
#pragma unroll
                for (int bj = 0; bj < 2; ++bj)
#pragma unroll
                    for (int n = 0; n < 2; ++n) *(f32x4*)(rowp + bj * HALF + n * 16) = acc[ai][bj][m][n]; }
    }
};

struct EpiWin {
    static constexpr bool PERM = true, AFTER_DRAIN = false;
    bf16_t *S1, *U, *GBS, *ZS; const float* rs; float* convp; float* convs;
    __device__ __forceinline__ void operator()(const f32x4 (&acc)[2][2][4][2], const Unit& u, int wr, int wc, int fr, int fq) const {
        const int row0 = u.pm * BM + wr * 64 + fr;
        if (u.pn < 16) {
            const int ch0 = (u.pn >> 1) * 128 + wc * 32 + fq * 8; const bool isu = (u.pn & 1) != 0;
#pragma unroll
            for (int ai = 0; ai < 2; ++ai)
#pragma unroll
                for (int m = 0; m < 4; ++m) {
                    const int row = row0 + ai * HALF + m * 16;
                    const float rsv = rs[row];
                    const f32x4 a0 = acc[ai][0][m][0] * rsv, a1 = acc[ai][0][m][1] * rsv, b0 = acc[ai][1][m][0] * rsv, b1 = acc[ai][1][m][1] * rsv;
                    f32x4 r0, r1;
                    if (isu) { r0 = a0 * b0; r1 = a1 * b1; }
                    else {
#pragma unroll
                        for (int j = 0; j < 4; ++j) { r0[j] = a0[j] * sigmoidf_(b0[j]); r1[j] = a1[j] * sigmoidf_(b1[j]); } }
                    u32x4 w; w.x = pk2(r0[0], r0[1]); w.y = pk2(r0[2], r0[3]); w.z = pk2(r1[0], r1[1]); w.w = pk2(r1[2], r1[3]);
                    *(u32x4*)((isu ? U : S1) + (size_t)row * DM + ch0) = w;
                    if (isu) {
                        if (row < TP) { const int tpos = row & (SEQ - 1), bl = row >> 11; if (tpos >= SEQ - 2) { float* cp = convp + (size_t)(bl * 2 + tpos - (SEQ - 2)) * DM + ch0; *(f32x4*)cp = r0; *(f32x4*)(cp + 4) = r1; } }
                        else { const int r2 = row - TP, tpos = r2 & (DSEQ - 1), bl = r2 >> 6; if (tpos >= DSEQ - 2) { float* cp = convs + (size_t)(bl * 2 + tpos - (DSEQ - 2)) * DM + ch0; *(f32x4*)cp = r0; *(f32x4*)(cp + 4) = r1; } }
                    }
                }
        } else {
            const bool gate = u.pn < 20;
            bf16_t* base = gate ? GBS : ZS; const int ld = gate ? DM : ZSW;
            const int col0 = (gate ? (u.pn - 16) : (u.pn - 20)) * 256 + wc * 32 + fq * 8;
#pragma unroll
            for (int ai = 0; ai < 2; ++ai)
#pragma unroll
                for (int m = 0; m < 4; ++m) { bf16_t* rowp = base + (size_t)(row0 + ai * HALF + m * 16) * ld + col0; const float rsv = rs[row0 + ai * HALF + m * 16];
#pragma unroll
                    for (int bj = 0; bj < 2; ++bj) { f32x4 v0 = acc[ai][bj][m][0] * rsv, v1 = acc[ai][bj][m][1] * rsv;
                        if (gate) {
#pragma unroll
                            for (int j = 0; j < 4; ++j) { v0[j] = sigmoidf_(v0[j]); v1[j] = sigmoidf_(v1[j]); } }
                        u32x4 w; w.x = pk2(v0[0], v0[1]); w.y = pk2(v0[2], v0[3]); w.z = pk2(v1[0], v1[1]); w.w = pk2(v1[2], v1[3]); *(u32x4*)(rowp + bj * HALF) = w; } }
        }
    }
};

struct EpiQ {
    static constexpr bool PERM = true, AFTER_DRAIN = false;
    bf16_t* Q; const f32x2* rope;
    __device__ __forceinline__ void operator()(const f32x4 (&acc)[2][2][4][2], const Unit& u, int wr, int wc, int fr, int fq) const {
        const int row0 = u.pm * BM + wr * 64 + fr;
        if (u.pn < 4) {
            bf16_t* base = Q + (size_t)row0 * NQ + (2 * u.pn) * QKD + wc * 32 + fq * 8;
#pragma unroll
            for (int ai = 0; ai < 2; ++ai)
#pragma unroll
                for (int m = 0; m < 4; ++m) { bf16_t* rowp = base + (size_t)(ai * HALF + m * 16) * NQ;
#pragma unroll
                    for (int bj = 0; bj < 2; ++bj) { const f32x4 v0 = acc[ai][bj][m][0] * QSCALE, v1 = acc[ai][bj][m][1] * QSCALE;
                        u32x4 w; w.x = pk2(v0[0], v0[1]); w.y = pk2(v0[2], v0[3]); w.z = pk2(v1[0], v1[1]); w.w = pk2(v1[2], v1[3]);
                        *(u32x4*)(rowp + bj * QKD) = w; } }
        } else {
            const int head = (u.pn - 4) * 4 + wc;
            bf16_t* base = Q + (size_t)row0 * NQ + head * QKD + 128 + fq * 8;
#pragma unroll
            for (int ai = 0; ai < 2; ++ai)
#pragma unroll
                for (int m = 0; m < 4; ++m) { const int row = row0 + ai * HALF + m * 16; const int pos = row_pos(row);
                    const f32x2* rp = rope + pos * 32 + fq * 8; bf16_t* rowp = base + (size_t)(ai * HALF + m * 16) * NQ;
                    unsigned wa[4], wb[4];
#pragma unroll
                    for (int n = 0; n < 2; ++n) { const f32x4 x1 = acc[ai][0][m][n], x2 = acc[ai][1][m][n];
                        const f32x4 cs01 = *(const f32x4*)(rp + n * 4), cs23 = *(const f32x4*)(rp + n * 4 + 2);
                        const float c0 = cs01[0], s0 = cs01[1], c1 = cs01[2], s1 = cs01[3], c2 = cs23[0], s2 = cs23[1], c3 = cs23[2], s3 = cs23[3];
                        wa[2 * n] = pk2((x1[0] * c0 - x2[0] * s0) * QSCALE, (x1[1] * c1 - x2[1] * s1) * QSCALE); wa[2 * n + 1] = pk2((x1[2] * c2 - x2[2] * s2) * QSCALE, (x1[3] * c3 - x2[3] * s3) * QSCALE);
                        wb[2 * n] = pk2((x2[0] * c0 + x1[0] * s0) * QSCALE, (x2[1] * c1 + x1[1] * s1) * QSCALE); wb[2 * n + 1] = pk2((x2[2] * c2 + x1[2] * s2) * QSCALE, (x2[3] * c3 + x1[3] * s3) * QSCALE); }
                    *(u32x4*)rowp = (u32x4){wa[0], wa[1], wa[2], wa[3]}; *(u32x4*)(rowp + 32) = (u32x4){wb[0], wb[1], wb[2], wb[3]};
                    asm volatile("" ::: "memory"); }
        }
    }
};

template <class Epi, class Sched, bool ALIGN_EPI = false, bool SP2 = false>
__device__ __forceinline__ void gemm_phase(PG8_LAS unsigned char* lds, const Gemm g, const Sched& S, const Epi& E) {
    int tid_ = threadIdx.x; asm volatile("" : "+v"(tid_));
    const int tid = tid_, wid = __builtin_amdgcn_readfirstlane(tid >> 6), lane = tid & 63, wr = wid >> 2, wc = wid & 3, fr = lane & 15, fq = lane >> 4;
    const int K = g.K, nt = K / BK;
    unsigned voffA[2], voffB[2];
#pragma unroll
    for (int i = 0; i < 2; ++i) { int R, C; stage_rc(tid * 16 + i * 8192, R, C); const int Rb = Epi::PERM ? ((R & ~31) + perm32(R & 31)) : R;
        voffA[i] = (unsigned)(R * g.lda + C) * 2u; voffB[i] = (unsigned)(Rb * g.ldb + C) * 2u; }
    const size_t kstep = (size_t)(BK * 2);
    const size_t hstepA = (size_t)HALF * g.lda * 2, hstepB = (size_t)HALF * g.ldb * 2;
    const size_t tstepA = 2 * hstepA, tstepB = 2 * hstepB, ksl = (size_t)K * 2;
    const unsigned ldsw = (unsigned)wid * 1024u;
    const int aoff = lds_byte(wr * 64 + fr, fq * 8), boff = lds_byte(wc * 32 + fr, fq * 8);
#define PG8_SA(b, h) (((b) * 2 + (h)) * HTB)
#define PG8_SB(b, h) ((4 + (b) * 2 + (h)) * HTB)
#define PG8_STAGE(bufoff, gbase, voff) do { _Pragma("unroll") for (int _i = 0; _i < 2; ++_i) \
        __builtin_amdgcn_global_load_lds((const unsigned*)((const char*)(gbase) + (voff)[_i]), (PG8_LAS unsigned*)(lds + (bufoff) + ldsw + _i * 8192), 16, 0, 0); } while (0)
#define PG8_LDA(dst, b, h) do { _Pragma("unroll") for (int m = 0; m < 4; ++m) _Pragma("unroll") for (int k = 0; k < 2; ++k) dst[m][k] = *(const PG8_LAS bf16x8*)(lds + PG8_SA(b, h) + aoff + m * 2048 + k * 1024); } while (0)
#define PG8_LDB(dst, b, h) do { _Pragma("unroll") for (int n = 0; n < 2; ++n) _Pragma("unroll") for (int k = 0; k < 2; ++k) dst[n][k] = *(const PG8_LAS bf16x8*)(lds + PG8_SB(b, h) + boff + n * 2048 + k * 1024); } while (0)
#define PG8_MMA(ai, bj, At, Bt) do { __builtin_amdgcn_s_setprio(1); _Pragma("unroll") for (int m = 0; m < 4; ++m) _Pragma("unroll") for (int n = 0; n < 2; ++n) _Pragma("unroll") for (int k = 0; k < 2; ++k) \
        acc[ai][bj][m][n] = __builtin_amdgcn_mfma_f32_16x16x32_bf16(Bt[n][k], At[m][k], acc[ai][bj][m][n], 0, 0, 0); __builtin_amdgcn_s_setprio(0); } while (0)
#define PG8_WAIT_V(n) asm volatile("s_waitcnt vmcnt(" #n ")" ::: "memory")
#define PG8_WAIT_L(n) asm volatile("s_waitcnt lgkmcnt(" #n ")" ::: "memory")
#define PG8_BAR __builtin_amdgcn_s_barrier()
#define PG8_SCHED __builtin_amdgcn_sched_barrier(0)
    Unit cur, nxt; int ui = 0;
    if (!S.next(0, cur)) return;
    f32x4 acc[2][2][4][2];
#pragma unroll
    for (int a = 0; a < 2; ++a)
#pragma unroll
        for (int b = 0; b < 2; ++b)
#pragma unroll
            for (int m = 0; m < 4; ++m)
#pragma unroll
                for (int n = 0; n < 2; ++n) acc[a][b][m][n] = (f32x4){0.f, 0.f, 0.f, 0.f};
    bf16x8 At[4][2], B0[2][2], B1[2][2];
    const char* cA = (const char*)g.A + (size_t)cur.pm * tstepA + (size_t)cur.ks * ksl; const char* cB = (const char*)g.Bt + (size_t)cur.pn * tstepB + (size_t)cur.ks * ksl;
    S.a_ready(cur);
    if constexpr (SP2) {
        PG8_STAGE(PG8_SB(0, 0), cB, voffB); PG8_STAGE(PG8_SB(0, 1), cB + hstepB, voffB); PG8_STAGE(PG8_SA(0, 0), cA, voffA); PG8_STAGE(PG8_SA(0, 1), cA + hstepA, voffA);
        if (wr == 1) PG8_BAR;
        PG8_WAIT_V(2); PG8_BAR;
        PG8_STAGE(PG8_SB(1, 0), cB + kstep, voffB); PG8_STAGE(PG8_SA(1, 0), cA + kstep, voffA); PG8_STAGE(PG8_SB(1, 1), cB + hstepB + kstep, voffB);
        PG8_WAIT_V(6); PG8_BAR;
    } else {
        PG8_STAGE(PG8_SB(0, 0), cB, voffB); PG8_STAGE(PG8_SA(0, 0), cA, voffA); PG8_STAGE(PG8_SB(0, 1), cB + hstepB, voffB); PG8_STAGE(PG8_SA(0, 1), cA + hstepA, voffA);
        if (wr == 1) PG8_BAR;
        PG8_WAIT_V(4); PG8_BAR;
        PG8_STAGE(PG8_SB(1, 0), cB + kstep, voffB); PG8_STAGE(PG8_SA(1, 0), cA + kstep, voffA); PG8_STAGE(PG8_SB(1, 1), cB + hstepB + kstep, voffB);
        PG8_WAIT_V(6); PG8_BAR;
    }
    for (;;) {
        const bool has_next = S.next(ui + 1, nxt);
        const char* nA = has_next ? (const char*)g.A + (size_t)nxt.pm * tstepA + (size_t)nxt.ks * ksl : cA; const char* nB = has_next ? (const char*)g.Bt + (size_t)nxt.pn * tstepB + (size_t)nxt.ks * ksl : cB;
        for (int t = 0; t < nt; t += 2) {
            const bool last = (t == nt - 2);
            const char* a1 = cA + (size_t)(t + 1) * kstep;
            const char* a2 = last ? nA : cA + (size_t)(t + 2) * kstep; const char* b2 = last ? nB : cB + (size_t)(t + 2) * kstep;
            const char* a3 = a2 + kstep; const char* b3 = b2 + kstep;
            if (last && has_next) S.a_ready(nxt);
            if constexpr (SP2) {
            PG8_LDB(B0, 0, 0); PG8_LDB(B1, 0, 1); PG8_SCHED; PG8_LDA(At, 0, 0); PG8_STAGE(PG8_SA(1, 1), a1 + hstepA, voffA);
            PG8_WAIT_V(8); PG8_WAIT_L(0); PG8_BAR; PG8_MMA(0, 0, At, B0); PG8_MMA(0, 1, At, B1); PG8_BAR; PG8_SCHED;
            PG8_LDA(At, 0, 1); PG8_STAGE(PG8_SB(0, 0), b2, voffB); PG8_STAGE(PG8_SB(0, 1), b2 + hstepB, voffB); PG8_STAGE(PG8_SA(0, 0), a2, voffA);
            PG8_WAIT_V(8); PG8_WAIT_L(0); PG8_BAR; PG8_MMA(1, 0, At, B0); PG8_MMA(1, 1, At, B1); PG8_BAR; PG8_SCHED;
            PG8_LDB(B0, 1, 0); PG8_LDB(B1, 1, 1); PG8_SCHED; PG8_LDA(At, 1, 0); PG8_STAGE(PG8_SA(0, 1), a2 + hstepA, voffA);
            PG8_WAIT_V(8); PG8_WAIT_L(0); PG8_BAR; PG8_MMA(0, 0, At, B0); PG8_MMA(0, 1, At, B1); PG8_BAR; PG8_SCHED;
            PG8_LDA(At, 1, 1); PG8_STAGE(PG8_SB(1, 0), b3, voffB); PG8_STAGE(PG8_SB(1, 1), b3 + hstepB, voffB); PG8_STAGE(PG8_SA(1, 0), a3, voffA);
            PG8_WAIT_V(8); PG8_WAIT_L(0); PG8_BAR; PG8_MMA(1, 0, At, B0); PG8_MMA(1, 1, At, B1); PG8_BAR; PG8_SCHED;
            } else {
            PG8_LDB(B0, 0, 0); PG8_SCHED; PG8_LDA(At, 0, 0); PG8_STAGE(PG8_SA(1, 1), a1 + hstepA, voffA);
            PG8_WAIT_L(8); PG8_BAR; PG8_WAIT_L(0); PG8_MMA(0, 0, At, B0); PG8_BAR; PG8_SCHED;
            PG8_LDB(B1, 0, 1); PG8_STAGE(PG8_SB(0, 0), b2, voffB);
            PG8_BAR; PG8_WAIT_L(0); PG8_MMA(0, 1, At, B1); PG8_BAR;
            PG8_LDA(At, 0, 1); PG8_STAGE(PG8_SA(0, 0), a2, voffA);
            PG8_BAR; PG8_WAIT_L(0); PG8_MMA(1, 0, At, B0); PG8_BAR; PG8_SCHED;
            PG8_STAGE(PG8_SB(0, 1), b2 + hstepB, voffB);
            PG8_WAIT_V(6); PG8_BAR; PG8_MMA(1, 1, At, B1); PG8_BAR;
            PG8_LDB(B0, 1, 0); PG8_SCHED; PG8_LDA(At, 1, 0); PG8_STAGE(PG8_SA(0, 1), a2 + hstepA, voffA);
            PG8_WAIT_L(8); PG8_BAR; PG8_WAIT_L(0); PG8_MMA(0, 0, At, B0); PG8_BAR; PG8_SCHED;
            PG8_LDB(B1, 1, 1); PG8_STAGE(PG8_SB(1, 0), b3, voffB);
            PG8_BAR; PG8_WAIT_L(0); PG8_MMA(0, 1, At, B1); PG8_BAR;
            PG8_LDA(At, 1, 1); PG8_STAGE(PG8_SA(1, 0), a3, voffA);
            PG8_BAR; PG8_WAIT_L(0); PG8_MMA(1, 0, At, B0); PG8_BAR; PG8_SCHED;
            PG8_STAGE(PG8_SB(1, 1), b3 + hstepB, voffB);
            PG8_WAIT_V(6); PG8_BAR; PG8_MMA(1, 1, At, B1); PG8_BAR;
            }
        }
        if constexpr (ALIGN_EPI) { if (wr == 0) PG8_BAR; }
        if constexpr (!Epi::AFTER_DRAIN) { int t2_ = threadIdx.x; asm volatile("" : "+v"(t2_)); const int fr2 = t2_ & 15, fq2 = (t2_ >> 4) & 3;
            E(acc, cur, wr, wc, fr2, fq2); S.done(cur); }
        if (!has_next) break;
#pragma unroll
        for (int a = 0; a < 2; ++a)
#pragma unroll
            for (int b = 0; b < 2; ++b)
#pragma unroll
                for (int m = 0; m < 4; ++m)
#pragma unroll
                    for (int n = 0; n < 2; ++n) acc[a][b][m][n] = (f32x4){0.f, 0.f, 0.f, 0.f};
        cur = nxt; cA = nA; cB = nB; ++ui;
        if constexpr (ALIGN_EPI) { if (wr == 1) PG8_BAR; }
    }
    PG8_WAIT_V(0);
    if constexpr (!ALIGN_EPI) { if (wr == 0) PG8_BAR; }
    PG8_BAR;
#undef PG8_SA
#undef PG8_SB
#undef PG8_STAGE
#undef PG8_LDA
#undef PG8_LDB
#undef PG8_MMA
#undef PG8_WAIT_V
#undef PG8_WAIT_L
#undef PG8_BAR
#undef PG8_SCHED
}
}

namespace att {
constexpr int KP = 400, VP = 144, KBUF = 64 * KP, VBUF = 128 * VP;
constexpr int OFF_K = 0, OFF_V = 2 * KBUF, OFF_SCR = 2 * KBUF + 2 * VBUF, LDS_NEED = OFF_SCR + 8 * 256;
constexpr int OSTG = 32 * 272;
static_assert(8 * OSTG <= OFF_SCR && LDS_NEED <= 131072, "attention LDS map");
struct Tensors { const bf16_t *Q, *KN, *KPE, *VT, *S1, *U, *GBS; bf16_t* XN; const float* convw; const float* state; };
__device__ __forceinline__ int crow(int r, int hi) { return (r & 3) + 8 * (r >> 2) + 4 * hi; }
#define MFMA32(a, b, c) __builtin_amdgcn_mfma_f32_32x32x16_bf16((a), (b), (c), 0, 0, 0)

__device__ __forceinline__ void unit(LAS unsigned char* lds, const Tensors& T, int h, int qrow0, int nact, bool sample, int limbase, int kv0, int kvnew, int nt) {
    int tid_ = threadIdx.x; asm volatile("" : "+v"(tid_));
    const int tid = tid_, lane = tid & 63, r32 = lane & 31, hi = lane >> 5; const int wid = __builtin_amdgcn_readfirstlane(tid >> 6);
    const bool active = wid < nact;
    const int lim = sample ? limbase : limbase + (wid >> 1);
    const char* kb[3]; int ks[3]; unsigned kd[3];
#pragma unroll
    for (int i = 0; i < 3; ++i) { const int c = tid + 512 * i, row = c / 24, cc = c % 24;
        if (cc < 16) { kb[i] = (const char*)T.KN + ((size_t)row * DM + h * 128 + cc * 8) * 2; ks[i] = DM * 2; }
        else { kb[i] = (const char*)T.KPE + ((size_t)row * 64 + (cc - 16) * 8) * 2; ks[i] = 64 * 2; }
        kd[i] = (unsigned)(row * KP + cc * 16); }
    const char* vb[2]; unsigned vd[2];
#pragma unroll
    for (int i = 0; i < 2; ++i) { const int c = tid + 512 * i, drow = c >> 3, cc = c & 7;
        vb[i] = (const char*)T.VT + ((size_t)(h * 128 + drow) * TA + cc * 8) * 2; vd[i] = (unsigned)(drow * VP + (cc >> 1) * 32 + (cc & 1) * 8); }
    u32x4 kreg[3], vreg[2];
#define ATT_ISSUE(t) do { const int trow_ = (sample && (t) == 32) ? kvnew : kv0 + 64 * (t); \
        _Pragma("unroll") for (int i_ = 0; i_ < 3; ++i_) kreg[i_] = *(const GAS u32x4*)(kb[i_] + (size_t)trow_ * ks[i_]); \
        _Pragma("unroll") for (int i_ = 0; i_ < 2; ++i_) vreg[i_] = *(const GAS u32x4*)(vb[i_] + (size_t)trow_ * 2); } while (0)
#define ATT_WRITE(buf) do { _Pragma("unroll") for (int i_ = 0; i_ < 3; ++i_) *(LAS u32x4*)(lds + OFF_K + (buf) * KBUF + kd[i_]) = kreg[i_]; \
        _Pragma("unroll") for (int i_ = 0; i_ < 2; ++i_) { LAS u32x2* d_ = (LAS u32x2*)(lds + OFF_V + (buf) * VBUF + vd[i_]); d_[0] = (u32x2){vreg[i_].x, vreg[i_].y}; d_[2] = (u32x2){vreg[i_].z, vreg[i_].w}; } } while (0)
    ATT_ISSUE(0);
    bf16x8 qf[12];
    { const bf16_t* qrow = T.Q + (size_t)(qrow0 + 32 * (active ? wid : 0) + r32) * NQ + h * QKD + hi * 8;
#pragma unroll
      for (int d0 = 0; d0 < 12; ++d0) qf[d0] = *(const GAS bf16x8*)(qrow + d0 * 16); }
    float mrun = -1e30f, lrun = 0.f;
    f32x16 o[4];
#pragma unroll
    for (int d = 0; d < 4; ++d)
#pragma unroll
        for (int r = 0; r < 16; ++r) o[d][r] = 0.f;
    LAS float* scr = (LAS float*)(lds + OFF_SCR + wid * 256);
    ATT_WRITE(0);
    __syncthreads();
    for (int t = 0; t < nt; ++t) {
        const int buf = t & 1;
        if (t + 1 < nt) ATT_ISSUE(t + 1);
        if (active && t <= lim) {
            const LAS unsigned char* kp = lds + OFF_K + buf * KBUF + r32 * KP + hi * 16;
            f32x16 p0, p1;
#pragma unroll
            for (int r = 0; r < 16; ++r) { p0[r] = 0.f; p1[r] = 0.f; }
            { bf16x8 kf[2][4];
#pragma unroll
              for (int i = 0; i < 2; ++i) { kf[0][2 * i] = *(const LAS bf16x8*)(kp + i * 32); kf[0][2 * i + 1] = *(const LAS bf16x8*)(kp + 32 * KP + i * 32); }
#pragma unroll
              for (int b = 0; b < 6; ++b) {
                  if (b < 5) {
#pragma unroll
                      for (int i = 0; i < 2; ++i) { kf[(b + 1) & 1][2 * i] = *(const LAS bf16x8*)(kp + (2 * (b + 1) + i) * 32); kf[(b + 1) & 1][2 * i + 1] = *(const LAS bf16x8*)(kp + 32 * KP + (2 * (b + 1) + i) * 32); } }
                  __builtin_amdgcn_sched_barrier(0);
#pragma unroll
                  for (int i = 0; i < 2; ++i) { p0 = MFMA32(kf[b & 1][2 * i], qf[2 * b + i], p0); p1 = MFMA32(kf[b & 1][2 * i + 1], qf[2 * b + i], p1); }
                  __builtin_amdgcn_sched_barrier(0);
              } }
            float rm = fmaxf(p0[0], p1[0]);
#pragma unroll
            for (int r = 1; r < 16; ++r) rm = fmaxf(rm, fmaxf(p0[r], p1[r]));
            rm = fmaxf(rm, __shfl_xor(rm, 32));
            const bool need = rm > mrun + 8.0f;
            if (__builtin_amdgcn_ballot_w64(need) != 0ull) {
                const float mn = need ? rm : mrun; const float alpha = __builtin_amdgcn_exp2f(mrun - mn); mrun = mn; lrun *= alpha;
                if (hi == 0) scr[r32] = alpha;
                asm volatile("s_waitcnt lgkmcnt(0)" ::: "memory");
#pragma unroll
                for (int r = 0; r < 16; ++r) { const float f = scr[crow(r, hi)];
#pragma unroll
                    for (int d = 0; d < 4; ++d) o[d][r] *= f; }
                asm volatile("s_waitcnt lgkmcnt(0)" ::: "memory");
            }
            { float ps = 0.f;
#pragma unroll
              for (int r = 0; r < 16; ++r) { p0[r] = __builtin_amdgcn_exp2f(p0[r] - mrun); p1[r] = __builtin_amdgcn_exp2f(p1[r] - mrun); ps += p0[r] + p1[r]; }
              lrun += ps; }
            const LAS unsigned char* vp = lds + OFF_V + buf * VBUF + r32 * VP + hi * 16;
            { u32x4 vf[2][4];
#pragma unroll
              for (int d = 0; d < 4; ++d) vf[0][d] = *(const LAS u32x4*)(vp + d * 32 * VP);
#pragma unroll
              for (int j = 0; j < 4; ++j) {
                  if (j < 3) {
#pragma unroll
                      for (int d = 0; d < 4; ++d) vf[(j + 1) & 1][d] = *(const LAS u32x4*)(vp + d * 32 * VP + (j + 1) * 32); }
                  u32x4 pw;
                  if (j == 0) { pw.x = pk2(p0[0], p0[1]); pw.y = pk2(p0[2], p0[3]); pw.z = pk2(p0[4], p0[5]); pw.w = pk2(p0[6], p0[7]); }
                  else if (j == 1) { pw.x = pk2(p0[8], p0[9]); pw.y = pk2(p0[10], p0[11]); pw.z = pk2(p0[12], p0[13]); pw.w = pk2(p0[14], p0[15]); }
                  else if (j == 2) { pw.x = pk2(p1[0], p1[1]); pw.y = pk2(p1[2], p1[3]); pw.z = pk2(p1[4], p1[5]); pw.w = pk2(p1[6], p1[7]); }
                  else { pw.x = pk2(p1[8], p1[9]); pw.y = pk2(p1[10], p1[11]); pw.z = pk2(p1[12], p1[13]); pw.w = pk2(p1[14], p1[15]); }
                  const bf16x8 pa = __builtin_bit_cast(bf16x8, pw);
                  __builtin_amdgcn_sched_barrier(0);
#pragma unroll
                  for (int d = 0; d < 4; ++d) o[d] = MFMA32(pa, __builtin_bit_cast(bf16x8, vf[j & 1][d]), o[d]);
                  __builtin_amdgcn_sched_barrier(0);
              } }
        }
        if (t + 1 < nt) ATT_WRITE(buf ^ 1);
        __syncthreads();
    }
    if (active) {
        lrun += __shfl_xor(lrun, 32);
        if (hi == 0) scr[r32] = __builtin_amdgcn_rcpf(lrun);
        asm volatile("s_waitcnt lgkmcnt(0)" ::: "memory");
        LAS unsigned char* stg = lds + wid * OSTG;
#pragma unroll
        for (int r = 0; r < 16; ++r) { const int q = crow(r, hi); const float f = scr[q];
#pragma unroll
            for (int d = 0; d < 4; ++d) *(LAS bf16_t*)(stg + q * 272 + (d * 32 + r32) * 2) = (bf16_t)(pk2(o[d][r] * f, 0.f) & 0xffffu); }
        asm volatile("s_waitcnt lgkmcnt(0)" ::: "memory");
        const int ch = lane & 15, col = h * 128 + ch * 8;
        float cw[3][8];
#pragma unroll
        for (int k = 0; k < 3; ++k) { const f32x4 a = *(const GAS f32x4*)(T.convw + k * DM + col), b = *(const GAS f32x4*)(T.convw + k * DM + col + 4);
            cw[k][0] = a[0]; cw[k][1] = a[1]; cw[k][2] = a[2]; cw[k][3] = a[3]; cw[k][4] = b[0]; cw[k][5] = b[1]; cw[k][6] = b[2]; cw[k][7] = b[3]; }
#pragma unroll 2
        for (int i = 0; i < 8; ++i) {
            const int rr = 4 * i + (lane >> 4); const int R = qrow0 + 32 * wid + rr;
            const u32x4 yw = *(const LAS u32x4*)(stg + rr * 272 + ch * 16);
            const u32x4 sw = *(const GAS u32x4*)(T.S1 + (size_t)R * DM + col), gw = *(const GAS u32x4*)(T.GBS + (size_t)R * DM + col), u0w = *(const GAS u32x4*)(T.U + (size_t)R * DM + col);
            float u1[8], u2[8];
            int tpos, bl; if (!sample) { tpos = R & (SEQ - 1); bl = 0; } else { tpos = (R - TP) & (DSEQ - 1); bl = (R - TP) >> 6; }
            if (tpos >= 1) { const u32x4 w = *(const GAS u32x4*)(T.U + (size_t)(R - 1) * DM + col);
                u1[0] = bflo(w.x); u1[1] = bfhi(w.x); u1[2] = bflo(w.y); u1[3] = bfhi(w.y); u1[4] = bflo(w.z); u1[5] = bfhi(w.z); u1[6] = bflo(w.w); u1[7] = bfhi(w.w); }
            else if (sample) { const f32x4 a = *(const GAS f32x4*)(T.state + (size_t)(bl * 2 + 1) * DM + col), b = *(const GAS f32x4*)(T.state + (size_t)(bl * 2 + 1) * DM + col + 4);
                u1[0] = a[0]; u1[1] = a[1]; u1[2] = a[2]; u1[3] = a[3]; u1[4] = b[0]; u1[5] = b[1]; u1[6] = b[2]; u1[7] = b[3]; }
            else {
#pragma unroll
                for (int e = 0; e < 8; ++e) u1[e] = 0.f; }
            if (tpos >= 2) { const u32x4 w = *(const GAS u32x4*)(T.U + (size_t)(R - 2) * DM + col);
                u2[0] = bflo(w.x); u2[1] = bfhi(w.x); u2[2] = bflo(w.y); u2[3] = bfhi(w.y); u2[4] = bflo(w.z); u2[5] = bfhi(w.z); u2[6] = bflo(w.w); u2[7] = bfhi(w.w); }
            else if (sample) { const int sr = tpos;
                const f32x4 a = *(const GAS f32x4*)(T.state + (size_t)(bl * 2 + sr) * DM + col), b = *(const GAS f32x4*)(T.state + (size_t)(bl * 2 + sr) * DM + col + 4);
                u2[0] = a[0]; u2[1] = a[1]; u2[2] = a[2]; u2[3] = a[3]; u2[4] = b[0]; u2[5] = b[1]; u2[6] = b[2]; u2[7] = b[3]; }
            else {
#pragma unroll
                for (int e = 0; e < 8; ++e) u2[e] = 0.f; }
            const unsigned yv[4] = {yw.x, yw.y, yw.z, yw.w}, sv[4] = {sw.x, sw.y, sw.z, sw.w}, gv[4] = {gw.x, gw.y, gw.z, gw.w}, uv[4] = {u0w.x, u0w.y, u0w.z, u0w.w};
            unsigned ow[4];
#pragma unroll
            for (int e = 0; e < 4; ++e) {
                const float ya = bflo(yv[e]), yb = bfhi(yv[e]), sa = bflo(sv[e]), sb = bfhi(sv[e]), ga = bflo(gv[e]), gb = bfhi(gv[e]), ua = bflo(uv[e]), ub = bfhi(uv[e]);
                const float ca = cw[0][2 * e] * u2[2 * e] + cw[1][2 * e] * u1[2 * e] + cw[2][2 * e] * ua;
                const float cb = cw[0][2 * e + 1] * u2[2 * e + 1] + cw[1][2 * e + 1] * u1[2 * e + 1] + cw[2][2 * e + 1] * ub;
                ow[e] = pk2(sa * ca + ga * ya, sb * cb + gb * yb);
            }
            *(GAS u32x4*)(T.XN + (size_t)R * DM + col) = (u32x4){ow[0], ow[1], ow[2], ow[3]};
        }
    }
    __syncthreads();
#undef ATT_ISSUE
#undef ATT_WRITE
}
}

#define XB_TMO      128
#define XB_XCNT(j)  (256  + 64 * (j))
#define XB_XSUB(j)  (1280 + 64 * (j))
#define XB_XGEN(j)  (2304 + 64 * (j))
#define XB_TOP      3328
#define XB_TOPGEN   3392
#define XCD_BAR_WORDS 3456
#define XB_SPIN_CAP (1u << 20)
__device__ __forceinline__ unsigned xb_ld(unsigned* p)              { return __hip_atomic_load(p, __ATOMIC_RELAXED, __HIP_MEMORY_SCOPE_AGENT); }
__device__ __forceinline__ unsigned xb_add(unsigned* p, unsigned v) { return __hip_atomic_fetch_add(p, v, __ATOMIC_RELAXED, __HIP_MEMORY_SCOPE_AGENT); }
__device__ __forceinline__ unsigned xb_xcc_id() { return (unsigned)__builtin_amdgcn_s_getreg((3 << 11) | 20) & 0xFu; }
#define XB_SPIN(cond, bar) do { unsigned _sp = 0; while (cond) { __builtin_amdgcn_s_sleep(1); \
    if ((++_sp & 255u) == 0u) { if (xb_ld(&(bar)[XB_TMO])) break; if (_sp > XB_SPIN_CAP) { atomicAdd(&(bar)[XB_TMO], 1u); break; } } } } while (0)
struct XcdBarrier { unsigned* bar; unsigned x; volatile LAS unsigned* st; };
__device__ __forceinline__ XcdBarrier xcd_barrier_post(unsigned* bar, volatile LAS unsigned* st) {
    XcdBarrier b; b.bar = bar; b.x = xb_xcc_id(); b.st = st;
    if (threadIdx.x == 0) (void)xb_add(&bar[XB_XCNT(b.x)], 1u);
    return b;
}
__device__ __forceinline__ void xcd_barrier_complete(unsigned* bar, unsigned x, unsigned& nloc, unsigned& nx) {
    const unsigned G = gridDim.x * gridDim.y * gridDim.z;
    unsigned sum, cnt, mine, sp = 0u;
    for (;;) {
        sum = 0u; cnt = 0u; mine = 0u;
#pragma unroll
        for (unsigned j = 0; j < 16; ++j) { const unsigned c = xb_ld(&bar[XB_XCNT(j)]); sum += c; cnt += (c > 0u) ? 1u : 0u; mine = (j == x) ? c : mine; }
        if (sum == G) break;
        __builtin_amdgcn_s_sleep(1);
        if ((++sp & 255u) == 0u) { if (xb_ld(&bar[XB_TMO])) break; if (sp > XB_SPIN_CAP) { atomicAdd(&bar[XB_TMO], 1u); break; } }
    }
    nloc = mine > 0u ? mine : 1u; nx = cnt > 0u ? cnt : 1u;
}
__device__ __forceinline__ void xcd_barrier(const XcdBarrier& b) {
    asm volatile("s_waitcnt vmcnt(0)" ::: "memory");
    __syncthreads();
    if (threadIdx.x == 0) {
        unsigned* bar = b.bar;
        __builtin_amdgcn_s_waitcnt(0);
        unsigned nloc = b.st[0], nx = b.st[1];
        if (nloc == 0u) { xcd_barrier_complete(bar, b.x, nloc, nx); b.st[0] = nloc; b.st[1] = nx; }
        const unsigned old = xb_add(&bar[XB_XSUB(b.x)], 1u);
        const unsigned gen = old / nloc;
        if (old + 1u == (gen + 1u) * nloc) {
            __builtin_amdgcn_fence(__ATOMIC_RELEASE, "agent");
            asm volatile("s_waitcnt vmcnt(0)" ::: "memory");
            const unsigned og = xb_add(&bar[XB_TOP], 1u);
            const unsigned tg = og / nx;
            if (og + 1u == (tg + 1u) * nx) xb_add(&bar[XB_TOPGEN], 1u);
            else XB_SPIN(xb_ld(&bar[XB_TOPGEN]) == tg, bar);
            __builtin_amdgcn_fence(__ATOMIC_ACQUIRE, "agent");
            xb_add(&bar[XB_XGEN(b.x)], 1u);
            asm volatile("s_waitcnt vmcnt(0)" ::: "memory");
        } else {
            XB_SPIN(xb_ld(&bar[XB_XGEN(b.x)]) == gen, bar);
            __builtin_amdgcn_fence(__ATOMIC_ACQUIRE, "agent");
            asm volatile("s_waitcnt vmcnt(0)" ::: "memory");
        }
    }
    __syncthreads();
}

constexpr int NWAVES = 8;
constexpr int LDS_BYTES = 147456;
constexpr size_t al256(size_t x) { return (x + 255) & ~(size_t)255; }
constexpr size_t W_WIN = (size_t)NWIN * DM * 2, W_UQ = (size_t)NQ * QL * 2, W_UK = (size_t)1024 * KVL * 2, W_UV = W_UK, W_O = (size_t)DM * DM * 2, W_1 = (size_t)DFF * DM * 2, W_2 = W_1;
constexpr size_t WL_WIN = 0, WL_UQ = WL_WIN + W_WIN, WL_UK = WL_UQ + W_UQ, WL_UV = WL_UK + W_UK, WL_O = WL_UV + W_UV, WL_1 = WL_O + W_O, WL_2 = WL_1 + W_1, WL_SIZE = WL_2 + W_2;
constexpr size_t WS_CTL = 0, CTL_BYTES = 16384;
constexpr size_t WS_ROPE = CTL_BYTES;
constexpr size_t WS_WB = al256(WS_ROPE + (size_t)NPOS * 32 * 8);
constexpr size_t WS_XN = al256(WS_WB + (size_t)DEPTH * WL_SIZE);
constexpr size_t WS_RSA = al256(WS_XN + (size_t)TG * DM * 2);
constexpr size_t WS_MG = al256(WS_RSA + (size_t)TG * 4);
constexpr size_t WS_OUT = al256(WS_MG + (size_t)TG * DM * 2);
constexpr size_t WS_CKVA = al256(WS_OUT + (size_t)TG * DM * 2);
constexpr size_t WS_KPEA = al256(WS_CKVA + (size_t)TA * KVL * 2);
constexpr size_t WS_Q = al256(WS_KPEA + (size_t)TA * 64 * 2);
constexpr size_t WS_KNA = al256(WS_Q + (size_t)TG * NQ * 2);
constexpr size_t WS_VTA = al256(WS_KNA + (size_t)TA * DM * 2);
constexpr size_t WS_S1 = al256(WS_VTA + (size_t)TA * DM * 2);
constexpr size_t WS_U = al256(WS_S1 + (size_t)TG * DM * 2);
constexpr size_t WS_GBS = al256(WS_U + (size_t)TG * DM * 2);
constexpr size_t WS_ZS = WS_OUT;
static_assert((size_t)TG * ZSW * 2 <= (size_t)TG * DM * 2, "ZS overlay");
constexpr size_t WS_CQN = al256(WS_GBS + (size_t)TG * DM * 2);
constexpr size_t WS_END0 = al256(WS_CQN + (size_t)TG * QL * 2);
constexpr size_t WS_PART = WS_END0;
constexpr size_t WS_END1 = al256(WS_PART + (size_t)16 * TS * DM * 4);
constexpr size_t WS_HID = WS_KNA;
static_assert(WS_HID + (size_t)TG * DFF * 2 <= WS_END0, "HID overlay");
constexpr size_t WS_END = WS_END1;

constexpr size_t O_YP = 0, O_YS = O_YP + (size_t)NBATCH * SEQ * DM, O_CKVP = O_YS + (size_t)NBATCH * DSEQ * DM, O_KPEP = O_CKVP + (size_t)DEPTH * NBATCH * SEQ * KVL,
                 O_CONVP = O_KPEP + (size_t)DEPTH * NBATCH * SEQ * 64, O_CKVS = O_CONVP + (size_t)DEPTH * NBATCH * 2 * DM, O_KPES = O_CKVS + (size_t)DEPTH * NBATCH * DSEQ * KVL,
                 O_CONVS = O_KPES + (size_t)DEPTH * NBATCH * DSEQ * 64, O_END = O_CONVS + (size_t)DEPTH * NBATCH * 2 * DM;

struct Args { const float* in[19]; float* out; unsigned char* ws; int ph_lo, ph_hi; };

__device__ __forceinline__ int srccol(int kind, int r) {
    if (kind == 0) {
        const int tile = r >> 8, lr = r & 255;
        if (tile < 16) { const int half = lr >> 7, ch = 128 * (tile >> 1) + (lr & 127);
            return ((tile & 1) ? (half ? 2048 : 1024) : (half ? 3776 : 0)) + ch; }
        if (tile < 20) return 4800 + (tile - 16) * 256 + lr;
        const int c = (tile - 20) * 256 + lr; return c < 704 ? 3072 + c : -1;
    }
    if (kind == 1) {
        const int tile = r >> 8, lr = r & 255;
        if (tile < 4) { const int head = r >> 7, d = r & 127; return head * QKD + d; }
        const int bj = lr >> 7, c = lr & 127, hl = c >> 5, i = c & 31; return ((tile - 4) * 4 + hl) * QKD + 128 + 32 * bj + i;
    }
    return r;
}
__device__ __forceinline__ void transpose_item(const float* W, int K, int N, bf16_t* WT, int ndest, int kind, LAS float* scr, int item, int lane, const float* gk = nullptr) {
    const int nblk = ndest / 32, kb = item / nblk, nb = item % nblk, k0 = 64 * kb, n0 = 32 * nb;
    const int sc = srccol(kind, n0 + (lane & 31));
#pragma unroll
    for (int i = 0; i < 32; ++i) { const int kk = 2 * i + (lane >> 5); scr[kk * 33 + (lane & 31)] = sc >= 0 ? W[(size_t)(k0 + kk) * N + sc] * (gk ? gk[k0 + kk] : 1.0f) : 0.f; }
    asm volatile("s_waitcnt lgkmcnt(0)" ::: "memory");
    const int c = lane & 7;
#pragma unroll
    for (int j = 0; j < 4; ++j) { const int n = (lane >> 3) + 8 * j; const LAS float* s = scr + (8 * c) * 33 + n;
        u32x4 o; o.x = pk2(s[0 * 33], s[1 * 33]); o.y = pk2(s[2 * 33], s[3 * 33]); o.z = pk2(s[4 * 33], s[5 * 33]); o.w = pk2(s[6 * 33], s[7 * 33]);
        *(u32x4*)(WT + (size_t)(n0 + n) * K + k0 + 8 * c) = o; }
    asm volatile("s_waitcnt lgkmcnt(0)" ::: "memory");
}

__device__ __forceinline__ void rms_row_to_bf16(const float* xrow, const float* g, bf16_t* orow, int lane) {
    const GAS f32x4* xr = (const GAS f32x4*)xrow + lane; const GAS f32x4* gr = (const GAS f32x4*)g + lane;
    f32x4 v[4]; float s = 0.f;
#pragma unroll
    for (int j = 0; j < 4; ++j) { v[j] = xr[64 * j]; s += (v[j][0] * v[j][0] + v[j][1] * v[j][1]) + (v[j][2] * v[j][2] + v[j][3] * v[j][3]); }
    const float rs = 1.0f / sqrtf(wave_sum(s) * (1.f / DM) + EPS);
    GAS u32x2* o8 = (GAS u32x2*)orow + lane;
#pragma unroll
    for (int j = 0; j < 4; ++j) { const f32x4 gg = gr[64 * j]; u32x2 w; w.x = pk2(v[j][0] * rs * gg[0], v[j][1] * rs * gg[1]); w.y = pk2(v[j][2] * rs * gg[2], v[j][3] * rs * gg[3]); o8[64 * j] = w; }
}
template <int NSL> __device__ __forceinline__ void resid_row(const float* part, const float* xf, bf16_t* xr, float* rsp, const f32x4 (&g1v)[4], float* ydst, int lane) {
    f32x4 ov[4], xv[4]; float s = 0.f;
#pragma unroll
    for (int j = 0; j < 4; ++j) { const GAS f32x4* pr = (const GAS f32x4*)part + lane + 64 * j; f32x4 pv[NSL];
#pragma unroll
        for (int sl = 0; sl < NSL; ++sl) pv[sl] = pr[(size_t)sl * (TS * DM / 4)];
        f32x4 sacc = pv[0];
#pragma unroll
        for (int sl = 1; sl < NSL; ++sl) sacc += pv[sl];
        ov[j] = sacc;
        if (xf) xv[j] = ((const GAS f32x4*)xf + lane)[64 * j]; else { const u32x2 w = ((const GAS u32x2*)xr + lane)[64 * j]; xv[j] = (f32x4){bflo(w.x), bfhi(w.x), bflo(w.y), bfhi(w.y)}; }
        s += (ov[j][0] * ov[j][0] + ov[j][1] * ov[j][1]) + (ov[j][2] * ov[j][2] + ov[j][3] * ov[j][3]); }
    const float rs = 1.0f / sqrtf(wave_sum(s) * (1.f / DM) + EPS);
    float s2 = 0.f;
#pragma unroll
    for (int j = 0; j < 4; ++j) { xv[j] = xv[j] + ov[j] * rs * g1v[j]; s2 += (xv[j][0] * xv[j][0] + xv[j][1] * xv[j][1]) + (xv[j][2] * xv[j][2] + xv[j][3] * xv[j][3]); }
    const float rs2 = 1.0f / sqrtf(wave_sum(s2) * (1.f / DM) + EPS);
    if (lane == 0) *rsp = rs2;
#pragma unroll
    for (int j = 0; j < 4; ++j) { u32x2 w; w.x = pk2(xv[j][0], xv[j][1]); w.y = pk2(xv[j][2], xv[j][3]); ((GAS u32x2*)xr + lane)[64 * j] = w; if (ydst) ((GAS f32x4*)ydst + lane)[64 * j] = xv[j]; }
}
template <int NSL> __device__ __forceinline__ void resid_phase(const bf16_t* OUTB, const float* PART, const float* xf_p, const float* xf_s, bf16_t* XR, float* RS, const float* g1, float* y_p, float* y_s, int gw, int NGW, int lane) {
    constexpr int NB = 4;
    f32x4 g1v[4];
#pragma unroll
    for (int j = 0; j < 4; ++j) g1v[j] = ((const GAS f32x4*)g1 + lane)[64 * j];
#pragma unroll 1
    for (int R0 = gw; R0 < TP; R0 += NB * NGW) {
        f32x4 xv[NB][4]; u32x2 ow[NB][4];
        if (xf_p) {
#pragma unroll
            for (int b = 0; b < NB; ++b) { const int R = R0 + b * NGW, Rc = R < TP ? R : TP - 1;
#pragma unroll
                for (int j = 0; j < 4; ++j) { ow[b][j] = ((const GAS u32x2*)(OUTB + (size_t)Rc * DM) + lane)[64 * j]; xv[b][j] = ((const GAS f32x4*)(xf_p + (size_t)Rc * DM) + lane)[64 * j]; } }
        } else {
            u32x2 xw[NB][4];
#pragma unroll
            for (int b = 0; b < NB; ++b) { const int R = R0 + b * NGW, Rc = R < TP ? R : TP - 1;
#pragma unroll
                for (int j = 0; j < 4; ++j) { ow[b][j] = ((const GAS u32x2*)(OUTB + (size_t)Rc * DM) + lane)[64 * j]; xw[b][j] = ((const GAS u32x2*)(XR + (size_t)Rc * DM) + lane)[64 * j]; } }
#pragma unroll
            for (int b = 0; b < NB; ++b)
#pragma unroll
                for (int j = 0; j < 4; ++j) xv[b][j] = (f32x4){bflo(xw[b][j].x), bfhi(xw[b][j].x), bflo(xw[b][j].y), bfhi(xw[b][j].y)};
        }
#pragma unroll
        for (int b = 0; b < NB; ++b) { const int R = R0 + b * NGW;
            f32x4 ov[4]; float s = 0.f;
#pragma unroll
            for (int j = 0; j < 4; ++j) { const u32x2 w = ow[b][j]; ov[j] = (f32x4){bflo(w.x), bfhi(w.x), bflo(w.y), bfhi(w.y)}; s += (ov[j][0] * ov[j][0] + ov[j][1] * ov[j][1]) + (ov[j][2] * ov[j][2] + ov[j][3] * ov[j][3]); }
            const float rs = 1.0f / sqrtf(wave_sum(s) * (1.f / DM) + EPS);
            float s2 = 0.f;
#pragma unroll
            for (int j = 0; j < 4; ++j) { xv[b][j] = xv[b][j] + ov[j] * rs * g1v[j]; s2 += (xv[b][j][0] * xv[b][j][0] + xv[b][j][1] * xv[b][j][1]) + (xv[b][j][2] * xv[b][j][2] + xv[b][j][3] * xv[b][j][3]); }
            const float rs2 = 1.0f / sqrtf(wave_sum(s2) * (1.f / DM) + EPS);
            if (R < TP) {
                if (lane == 0) RS[R] = rs2;
                GAS u32x2* o8 = (GAS u32x2*)(XR + (size_t)R * DM) + lane;
#pragma unroll
                for (int j = 0; j < 4; ++j) { u32x2 w; w.x = pk2(xv[b][j][0], xv[b][j][1]); w.y = pk2(xv[b][j][2], xv[b][j][3]); o8[64 * j] = w; }
                if (y_p) { GAS f32x4* yo = (GAS f32x4*)(y_p + (size_t)R * DM) + lane;
#pragma unroll
                    for (int j = 0; j < 4; ++j) yo[64 * j] = xv[b][j]; }
            }
        }
    }
#pragma unroll 1
    for (int R = TP + gw; R < TG; R += NGW)
        resid_row<NSL>(PART + (size_t)(R - TP) * DM, xf_s ? xf_s + (size_t)(R - TP) * DM : nullptr, XR + (size_t)R * DM, RS + R, g1v, y_s ? y_s + (size_t)(R - TP) * DM : nullptr, lane);
}

constexpr int NPH_G = 1 + 9 * DEPTH, NPH = NG * NPH_G;
constexpr int NS5 = 4, NS8 = 8;

__global__ void __launch_bounds__(NWAVES * 64, 2) mega_fwd(Args a) {
    extern __shared__ __attribute__((aligned(16))) unsigned char lds_raw[];
    LAS unsigned char* lds = (LAS unsigned char*)lds_raw;
    cg::grid_group grid = cg::this_grid();
    { volatile LAS unsigned* st0 = (volatile LAS unsigned*)(lds + 131072); if (threadIdx.x < 4) st0[threadIdx.x] = 0u; __syncthreads(); }
    const XcdBarrier xbar = xcd_barrier_post((unsigned*)(a.ws + WS_CTL), (volatile LAS unsigned*)(lds + 131072));
    int ph = 0;
    const int lo = a.ph_lo, hi = a.ph_hi;
#define PH_BEGIN if (ph >= lo && ph < hi) { \
    int tid = threadIdx.x; asm volatile("" : "+v"(tid)); const int lane = tid & 63; (void)lane; const int wave = __builtin_amdgcn_readfirstlane(tid >> 6); \
    int G = gridDim.x, bx = blockIdx.x; asm volatile("" : "+s"(G), "+s"(bx)); \
    const int vcu = (G % 8 == 0) ? (bx % 8) * (G / 8) + bx / 8 : bx; const int gw = vcu * NWAVES + wave, NGW = G * NWAVES; (void)gw; (void)NGW; \
    int g = g0, l = l0; asm volatile("" : "+s"(g), "+s"(l)); (void)l; \
    unsigned char* ws = a.ws; float* out = a.out; asm volatile("" : "+s"(ws), "+s"(out)); \
    const f32x2* rope = (const f32x2*)(ws + WS_ROPE); (void)rope; \
    bf16_t* XN = (bf16_t*)(ws + WS_XN); bf16_t* OUTB = (bf16_t*)(ws + WS_OUT); bf16_t* CKVA = (bf16_t*)(ws + WS_CKVA); bf16_t* KPEA = (bf16_t*)(ws + WS_KPEA); \
    bf16_t* QB = (bf16_t*)(ws + WS_Q); bf16_t* KNA = (bf16_t*)(ws + WS_KNA); bf16_t* VTA = (bf16_t*)(ws + WS_VTA); bf16_t* S1 = (bf16_t*)(ws + WS_S1); \
    bf16_t* UB = (bf16_t*)(ws + WS_U); bf16_t* GBS = (bf16_t*)(ws + WS_GBS); bf16_t* ZS = (bf16_t*)(ws + WS_ZS); bf16_t* CQN = (bf16_t*)(ws + WS_CQN); bf16_t* HID = (bf16_t*)(ws + WS_HID); float* PART = (float*)(ws + WS_PART); (void)PART; bf16_t* MG = (bf16_t*)(ws + WS_MG); float* RSA = (float*)(ws + WS_RSA); (void)MG; (void)RSA; \
    (void)XN; (void)OUTB; (void)CKVA; (void)KPEA; (void)QB; (void)KNA; (void)VTA; (void)S1; (void)UB; (void)GBS; (void)ZS; (void)CQN; (void)HID; \
    const float* xp_in = a.in[0] + (size_t)g * TP * DM; const float* xs_in = a.in[1] + (size_t)g * TS * DM; (void)xp_in; (void)xs_in; \
    float* xp = out + O_YP + (size_t)g * TP * DM; float* xs = out + O_YS + (size_t)g * TS * DM; (void)xp; (void)xs; \
    const unsigned char* wl = ws + WS_WB + (size_t)l * WL_SIZE; (void)wl;
#define PH_END } ++ph; if (ph - 1 >= lo && ph < hi) { if (ph == 1) grid.sync(); else xcd_barrier(xbar); }

#pragma unroll 1
    for (int g0 = 0; g0 < NG; ++g0) {
        { const int l0 = 0;

        PH_BEGIN
        if (g == 0) {
            LAS float* scr = (LAS float*)(lds + wave * 16384);
            constexpr int I_WIN = (DM / 64) * (NWIN / 32), I_UQ = (QL / 64) * (NQ / 32), I_UK = (KVL / 64) * (1024 / 32), I_O = (DM / 64) * (DM / 32), I_1 = (DM / 64) * (DFF / 32), I_2 = (DFF / 64) * (DM / 32);
            constexpr int I_L = I_WIN + I_UQ + 2 * I_UK + I_O + I_1 + I_2;
            for (int it = gw; it < DEPTH * I_L; it += NGW) {
                const int ll = it / I_L; int r = it % I_L; bf16_t* wl2 = (bf16_t*)(ws + WS_WB + (size_t)ll * WL_SIZE);
                if (r < I_WIN) { transpose_item(a.in[5] + (size_t)ll * DM * DIN, DM, DIN, (bf16_t*)((char*)wl2 + WL_WIN), NWIN, 0, scr, r, lane, a.in[13] + (size_t)ll * DM); continue; } r -= I_WIN;
                if (r < I_UQ) { transpose_item(a.in[7] + (size_t)ll * QL * NQ, QL, NQ, (bf16_t*)((char*)wl2 + WL_UQ), NQ, 1, scr, r, lane); continue; } r -= I_UQ;
                if (r < I_UK) { transpose_item(a.in[8] + (size_t)ll * KVL * 1024, KVL, 1024, (bf16_t*)((char*)wl2 + WL_UK), 1024, 2, scr, r, lane); continue; } r -= I_UK;
                if (r < I_UK) { transpose_item(a.in[9] + (size_t)ll * KVL * 1024, KVL, 1024, (bf16_t*)((char*)wl2 + WL_UV), 1024, 2, scr, r, lane); continue; } r -= I_UK;
                if (r < I_O) { transpose_item(a.in[10] + (size_t)ll * DM * DM, DM, DM, (bf16_t*)((char*)wl2 + WL_O), DM, 2, scr, r, lane); continue; } r -= I_O;
                if (r < I_1) { transpose_item(a.in[11] + (size_t)ll * DM * DFF, DM, DFF, (bf16_t*)((char*)wl2 + WL_1), DFF, 2, scr, r, lane, a.in[15] + (size_t)ll * DM); continue; } r -= I_1;
                transpose_item(a.in[12] + (size_t)ll * DFF * DM, DFF, DM, (bf16_t*)((char*)wl2 + WL_2), DM, 2, scr, r, lane);
            }
            for (int idx = bx * 512 + tid; idx < NPOS * 32; idx += G * 512) {
                const int pos = idx >> 5, i = idx & 31; double inv = 1.0;
                for (int k = 0; k < i; ++k) inv *= 0.74989420933245582730;
                const float ang = (float)pos * (float)inv;
                const double rev = (double)ang * 0.15915494309189533577; const float fr = (float)(rev - __builtin_rint(rev));
                ((f32x2*)(ws + WS_ROPE))[idx] = (f32x2){__builtin_amdgcn_cosf(fr), __builtin_amdgcn_sinf(fr)};
            }
        }
        {
#pragma unroll 1
          for (int R0 = gw; R0 < TG; R0 += 4 * NGW) { f32x4 v[4][4];
#pragma unroll
              for (int b = 0; b < 4; ++b) { const int R = R0 + b * NGW, Rc = R < TG ? R : TG - 1; const float* xr = Rc < TP ? xp_in + (size_t)Rc * DM : xs_in + (size_t)(Rc - TP) * DM;
#pragma unroll
                  for (int j = 0; j < 4; ++j) v[b][j] = ((const GAS f32x4*)xr + lane)[64 * j]; }
#pragma unroll
              for (int b = 0; b < 4; ++b) { const int R = R0 + b * NGW; float sq = 0.f;
#pragma unroll
                  for (int j = 0; j < 4; ++j) sq += (v[b][j][0] * v[b][j][0] + v[b][j][1] * v[b][j][1]) + (v[b][j][2] * v[b][j][2] + v[b][j][3] * v[b][j][3]);
                  const float rs = 1.0f / sqrtf(wave_sum(sq) * (1.f / DM) + EPS);
                  if (R < TG) { GAS u32x2* o8 = (GAS u32x2*)(XN + (size_t)R * DM) + lane; if (lane == 0) RSA[R] = rs;
#pragma unroll
                      for (int j = 0; j < 4; ++j) { const f32x4 w = v[b][j]; u32x2 o; o.x = pk2(w[0], w[1]); o.y = pk2(w[2], w[3]); o8[64 * j] = o; } } } } }
        PH_END
        }
#pragma unroll 1
        for (int l0 = 0; l0 < DEPTH; ++l0) {
            PH_BEGIN
            { pg8::Gemm gm = pg8::mkgemm(XN, (const bf16_t*)(wl + WL_WIN), TG, NWIN, DM); pg8::StaticOrder S; S.init(TG, NWIN, G, bx);
              pg8::EpiWin E{S1, UB, GBS, ZS, RSA, out + O_CONVP + (size_t)(l * NBATCH + g * GB) * 2 * DM, out + O_CONVS + (size_t)(l * NBATCH + g * GB) * 2 * DM};
              pg8::gemm_phase<pg8::EpiWin, pg8::StaticOrder, true, true>(lds, gm, S, E); }
            PH_END
            PH_BEGIN
            {
                const float* gq = a.in[17] + (size_t)l * QL; const float* gkv = a.in[18] + (size_t)l * KVL;
                constexpr int NB = 4;
                f32x2 gqv[3];
#pragma unroll
                for (int j = 0; j < 3; ++j) gqv[j] = *(const GAS f32x2*)(gq + 128 * j + 2 * lane);
                const f32x4 gk = *(const GAS f32x4*)(gkv + 4 * lane);
#pragma unroll 1
                for (int R0 = gw; R0 < TG; R0 += NB * NGW) {
                    unsigned cw[NB][3]; u32x2 kw[NB]; bf16_t p1[NB], p2[NB]; f32x2 cs[NB];
#pragma unroll
                    for (int b = 0; b < NB; ++b) { const int R = R0 + b * NGW, Rc = R < TG ? R : TG - 1; const bf16_t* z = ZS + (size_t)Rc * ZSW;
#pragma unroll
                        for (int j = 0; j < 3; ++j) cw[b][j] = *(const GAS unsigned*)(z + 128 * j + 2 * lane);
                        kw[b] = *(const GAS u32x2*)(z + 384 + 4 * lane);
                        p1[b] = *(const GAS bf16_t*)(z + 640 + (lane & 31)); p2[b] = *(const GAS bf16_t*)(z + 672 + (lane & 31));
                        cs[b] = *(const GAS f32x2*)(rope + row_pos(Rc) * 32 + (lane & 31)); }
#pragma unroll
                    for (int b = 0; b < NB; ++b) { const int R = R0 + b * NGW;
                        float cq[6]; float s = 0.f;
#pragma unroll
                        for (int j = 0; j < 3; ++j) { cq[2 * j] = bflo(cw[b][j]); cq[2 * j + 1] = bfhi(cw[b][j]); s += cq[2 * j] * cq[2 * j] + cq[2 * j + 1] * cq[2 * j + 1]; }
                        const float rsq = 1.0f / sqrtf(wave_sum(s) * (1.f / QL) + EPS);
                        f32x4 kv = {bflo(kw[b].x), bfhi(kw[b].x), bflo(kw[b].y), bfhi(kw[b].y)};
                        const float rsk = 1.0f / sqrtf(wave_sum((kv[0] * kv[0] + kv[1] * kv[1]) + (kv[2] * kv[2] + kv[3] * kv[3])) * (1.f / KVL) + EPS);
                        if (R < TG) {
#pragma unroll
                            for (int j = 0; j < 3; ++j) *(GAS unsigned*)(CQN + (size_t)R * QL + 128 * j + 2 * lane) = pk2(cq[2 * j] * rsq * gqv[j][0], cq[2 * j + 1] * rsq * gqv[j][1]);
                            kv = kv * rsk * gk;
                            float* ockv = R < TP ? out + O_CKVP + ((size_t)l * NBATCH * SEQ + (size_t)g * TP + R) * KVL : out + O_CKVS + ((size_t)l * NBATCH * DSEQ + (size_t)g * TS + (R - TP)) * KVL;
                            *(GAS f32x4*)(ockv + 4 * lane) = kv;
                            u32x2 kb; kb.x = pk2(kv[0], kv[1]); kb.y = pk2(kv[2], kv[3]); *(GAS u32x2*)(CKVA + (size_t)R * KVL + 4 * lane) = kb;
                            if (lane < 32) {
                                const float x1 = __uint_as_float((unsigned)p1[b] << 16), x2 = __uint_as_float((unsigned)p2[b] << 16);
                                const float o1 = x1 * cs[b][0] - x2 * cs[b][1], o2 = x2 * cs[b][0] + x1 * cs[b][1];
                                float* okpe = R < TP ? out + O_KPEP + ((size_t)l * NBATCH * SEQ + (size_t)g * TP + R) * 64 : out + O_KPES + ((size_t)l * NBATCH * DSEQ + (size_t)g * TS + (R - TP)) * 64;
                                okpe[lane] = o1; okpe[32 + lane] = o2;
                                KPEA[(size_t)R * 64 + lane] = (bf16_t)(pk2(o1, 0.f) & 0xffffu); KPEA[(size_t)R * 64 + 32 + lane] = (bf16_t)(pk2(o2, 0.f) & 0xffffu);
                            }
                        }
                    }
                }
                const float* pc = a.in[2] + ((size_t)l * NBATCH + g * GB) * PAST * KVL; const float* pk = a.in[3] + ((size_t)l * NBATCH + g * GB) * PAST * 64;
                { const size_t nth = (size_t)G * 512, i0 = (size_t)bx * 512 + tid; constexpr size_t NC = (size_t)TPAST * KVL / 8, NK = (size_t)TPAST * 64 / 8;
#pragma unroll 1
                  for (size_t i = i0; i < NC; i += 4 * nth) { f32x4 v[4][2];
#pragma unroll
                      for (int u = 0; u < 4; ++u) { const size_t ii = i + u * nth < NC ? i + u * nth : NC - 1; v[u][0] = *(const GAS f32x4*)(pc + ii * 8); v[u][1] = *(const GAS f32x4*)(pc + ii * 8 + 4); }
#pragma unroll
                      for (int u = 0; u < 4; ++u) if (i + u * nth < NC) *(GAS u32x4*)(CKVA + (size_t)TG * KVL + (i + u * nth) * 8) = (u32x4){pk2(v[u][0][0], v[u][0][1]), pk2(v[u][0][2], v[u][0][3]), pk2(v[u][1][0], v[u][1][1]), pk2(v[u][1][2], v[u][1][3])}; }
#pragma unroll 1
                  for (size_t i = i0; i < NK; i += nth) { const f32x4 v0 = *(const GAS f32x4*)(pk + i * 8), v1 = *(const GAS f32x4*)(pk + i * 8 + 4);
                      *(GAS u32x4*)(KPEA + (size_t)TG * 64 + i * 8) = (u32x4){pk2(v0[0], v0[1]), pk2(v0[2], v0[3]), pk2(v1[0], v1[1]), pk2(v1[2], v1[3])}; } }
            }
            PH_END
            PH_BEGIN
            { { pg8::Gemm gm = pg8::mkgemm(CQN, (const bf16_t*)(wl + WL_UQ), TG, NQ, QL); pg8::StaticOrder S; S.init(TG, NQ, G, bx);
                pg8::EpiQ E{QB, rope}; pg8::gemm_phase<pg8::EpiQ, pg8::StaticOrder, true, true>(lds, gm, S, E); }
              constexpr int n1 = (TG / 256) * (NQ / 256), n2 = (TA / 256) * 4;
#pragma unroll 1
              for (int k = 0; k < 2; ++k) {
                  pg8::Gemm gm = k == 0 ? pg8::mkgemm(CKVA, (const bf16_t*)(wl + WL_UK), TA, 1024, KVL) : pg8::mkgemm((const bf16_t*)(wl + WL_UV), CKVA, 1024, TA, KVL);
                  const int off = (k == 0 ? n1 : n1 + n2) % G; pg8::StaticOrder S; S.init(gm.M, gm.N, G, (bx + G - off) % G);
                  pg8::EpiPlain<0> E{k == 0 ? KNA : VTA, k == 0 ? (long)DM : (long)TA, nullptr};
                  pg8::gemm_phase<pg8::EpiPlain<0>, pg8::StaticOrder, true, true>(lds, gm, S, E);
              } }
            PH_END
            PH_BEGIN
            { att::Tensors T{QB, KNA, KPEA, VTA, S1, UB, GBS, MG, a.in[6] + (size_t)l * 3 * DM, a.in[4] + ((size_t)l * NBATCH + g * GB) * 2 * DM};
#pragma unroll 1
              for (int i = vcu; i < 1280; i += G) {
                  const int round = i >> 8, cu = i & 255, p = cu >> 1, odd = cu & 1, bl = p >> 3, h = p & 7;
                  const int qb = odd ? (round == 0 ? 7 : round == 1 ? 5 : round == 2 ? 0 : -1) : (round == 0 ? 6 : round == 1 ? 4 : round == 2 ? 3 : round == 3 ? 2 : 1);
                  if (qb >= 0) att::unit(lds, T, h, bl * SEQ + qb * 256, 8, false, 4 * qb, bl * SEQ, 0, 4 * qb + 4);
                  else if (round == 3) att::unit(lds, T, h, TP + bl * DSEQ, 2, true, 32, TG + bl * PAST, TP + bl * DSEQ, 33);
              } }
            PH_END
            PH_BEGIN
            { { pg8::Gemm gm = pg8::mkgemm(MG, (const bf16_t*)(wl + WL_O), TP, DM, DM); pg8::StaticOrder S; S.init(TP, DM, G, bx);
                pg8::EpiPlain<0> E{OUTB, (long)DM, nullptr}; pg8::gemm_phase<pg8::EpiPlain<0>, pg8::StaticOrder, true, true>(lds, gm, S, E); }
              { pg8::Gemm gm{MG + (size_t)TP * DM, (const bf16_t*)(wl + WL_O), TS, DM, DM / NS5, DM, DM}; pg8::SplitOrder S; S.init(TS, DM, NS5, G, bx);
                pg8::EpiPartial E{PART, (long)DM, (long)TS * DM}; pg8::gemm_phase<pg8::EpiPartial, pg8::SplitOrder, true, true>(lds, gm, S, E); } }
            PH_END
            PH_BEGIN
            resid_phase<NS5>(OUTB, PART, l == 0 ? xp_in : nullptr, l == 0 ? xs_in : nullptr, XN, RSA, a.in[14] + (size_t)l * DM, nullptr, nullptr, gw, NGW, lane);
            PH_END
            PH_BEGIN
            { pg8::Gemm gm = pg8::mkgemm(XN, (const bf16_t*)(wl + WL_1), TG, DFF, DM); pg8::StaticOrder S; S.init(TG, DFF, G, bx);
              pg8::EpiPlain<1> E{HID, (long)DFF, RSA}; pg8::gemm_phase<pg8::EpiPlain<1>, pg8::StaticOrder, true, true>(lds, gm, S, E); }
            PH_END
            PH_BEGIN
            { { pg8::Gemm gm = pg8::mkgemm(HID, (const bf16_t*)(wl + WL_2), TP, DM, DFF); pg8::StaticOrder S; S.init(TP, DM, G, bx);
                pg8::EpiPlain<0> E{OUTB, (long)DM, nullptr}; pg8::gemm_phase<pg8::EpiPlain<0>, pg8::StaticOrder, true, true>(lds, gm, S, E); }
              { pg8::Gemm gm{HID + (size_t)TP * DFF, (const bf16_t*)(wl + WL_2), TS, DM, DFF / NS8, DFF, DFF}; pg8::SplitOrder S; S.init(TS, DM, NS8, G, bx);
                pg8::EpiPartial E{PART, (long)DM, (long)TS * DM}; pg8::gemm_phase<pg8::EpiPartial, pg8::SplitOrder, true, true>(lds, gm, S, E); } }
            PH_END
            PH_BEGIN
            resid_phase<NS8>(OUTB, PART, nullptr, nullptr, XN, RSA, a.in[16] + (size_t)l * DM, (l + 1 < DEPTH) ? nullptr : xp, (l + 1 < DEPTH) ? nullptr : xs, gw, NGW, lane);
            PH_END
        }
    }
#undef PH_BEGIN
#undef PH_END
}

extern "C" void kernel_launch(void* const* d_in, const int* in_sizes, int n_in, void* d_out, int out_size, void* d_ws, size_t ws_size, hipStream_t stream) {
    static int grid = 0;
    if (grid == 0) {
        if (n_in != 19 || (size_t)out_size != O_END || ws_size < WS_END) { fprintf(stderr, "kernel_launch: shape/workspace mismatch: n_in %d out %d (want %zu) ws %zu (need %zu)\n", n_in, out_size, (size_t)O_END, ws_size, (size_t)WS_END); grid = -1; return; }
        int dev = 0, cus = 0, per_cu = 0;
        if (hipGetDevice(&dev) != hipSuccess || hipDeviceGetAttribute(&cus, hipDeviceAttributeMultiprocessorCount, dev) != hipSuccess) { grid = -1; return; }
        if (hipFuncSetAttribute((const void*)mega_fwd, hipFuncAttributeMaxDynamicSharedMemorySize, LDS_BYTES) != hipSuccess) { fprintf(stderr, "kernel_launch: hipFuncSetAttribute failed\n"); grid = -1; return; }
        if (hipOccupancyMaxActiveBlocksPerMultiprocessor(&per_cu, (const void*)mega_fwd, NWAVES * 64, LDS_BYTES) != hipSuccess || per_cu < 1) { fprintf(stderr, "kernel_launch: occupancy query says %d\n", per_cu); per_cu = 1; }
        (void)hipGetLastError();
        grid = cus * 1;
    }
    if (grid < 0) return;
    if (hipMemsetAsync((char*)d_ws + WS_CTL, 0, CTL_BYTES, stream) != hipSuccess) { fprintf(stderr, "kernel_launch: memset failed\n"); return; }
    Args a{};
    for (int i = 0; i < 19; ++i) a.in[i] = (const float*)d_in[i];
    a.out = (float*)d_out; a.ws = (unsigned char*)d_ws;
#if MK_MULTI
    for (int p = 0; p < NPH; ++p) { a.ph_lo = p; a.ph_hi = p + 1; hipLaunchKernelGGL(mega_fwd, dim3(grid), dim3(NWAVES * 64), LDS_BYTES, stream, a); }
#else
    a.ph_lo = 0; a.ph_hi = NPH;
    void* args[] = {&a};
    hipError_t e = hipLaunchCooperativeKernel((const void*)mega_fwd, dim3(grid), dim3(NWAVES * 64), args, LDS_BYTES, stream);
    if (e != hipSuccess) fprintf(stderr, "kernel_launch: cooperative launch failed: %s (grid %d)\n", hipGetErrorString(e), grid);
#endif
}
```
